# Optimizing an MI355X kernel written in HIP

```python
import jax, jax.numpy as jnp
from jax import lax
import numpy as np

D_MODEL = 1024
BATCH = 2
SEQ = 16384
DEPTH = 4

N_MEM = 256
ROPE_THETA = 500000.0
EPS = 1e-6
BLOCK = 128
NEG = -1e30

MLA_HEADS = 8
MLA_NOPE = 64
MLA_ROPE = 32
MLA_V = 64
MLA_Q_LORA = 256
MLA_KV_LORA = 128

ML_HEADS = 4
ML_DK = 64
ML_DV = 64
ML_CONV = 4
ML_CHUNK = 128

SW_HEADS = 4
SW_HD = 64
SW_ROT = SW_HD // 4
SW_CONFIGS = ((128, 1), (512, 4), (2048, 16))

X_HEADS = 4
X_HD = D_MODEL // X_HEADS

D_FF = 256 * (-(-(8 * D_MODEL) // (3 * 256)))

MLA_W = MLA_HEADS * MLA_V
ML_W = ML_HEADS * ML_DV
SW_W = SW_HEADS * SW_HD
D_MIX = MLA_W + ML_W + SW_W

IN_SIZES = (MLA_Q_LORA, MLA_KV_LORA, MLA_ROPE,
            ML_HEADS * ML_DK, ML_HEADS * ML_DK, ML_W, ML_W, ML_HEADS, ML_HEADS,
            SW_W, SW_W, SW_W)
D_IN = sum(IN_SIZES)

kernel_name = "hybrid_mla_mlstm_dilated_swa_trunk"


def rms_norm(x, g):
    xf = x.astype(jnp.float32)
    y = xf * lax.rsqrt(jnp.mean(xf * xf, axis=-1, keepdims=True) + EPS)
    return (y * g.astype(jnp.float32)).astype(x.dtype)


def rope_tables(seq, d_rot):
    inv = ROPE_THETA ** (-jnp.arange(0, d_rot, 2, dtype=jnp.float32) / d_rot)
    ang = jnp.arange(seq, dtype=jnp.float32)[:, None] * inv[None, :]
    return jnp.cos(ang), jnp.sin(ang)


def apply_rope(x, cos, sin):
    xf = x.astype(jnp.float32)
    half = xf.shape[-1] // 2
    x1, x2 = xf[..., :half], xf[..., half:]
    c = cos[None, :, None, :]
    s = sin[None, :, None, :]
    return jnp.concatenate([x1 * c - x2 * s, x2 * c + x1 * s], axis=-1).astype(x.dtype)


def partial_rope(x, cos, sin):
    return jnp.concatenate([apply_rope(x[..., :SW_ROT], cos, sin), x[..., SW_ROT:]], axis=-1)


def causal_block_attention(q, k, v, scale):
    B, S, H, Dk = q.shape
    Dv = v.shape[-1]
    nb = S // BLOCK
    qb = q.reshape(B, nb, BLOCK, H, Dk).transpose(1, 0, 2, 3, 4)
    kpos = jnp.arange(S)

    def one(args):
        q_blk, blk = args
        s = jnp.einsum('bqhd,bkhd->bhqk', q_blk, k, preferred_element_type=jnp.float32) * scale
        qpos = blk * BLOCK + jnp.arange(BLOCK)
        s = jnp.where(kpos[None, :] <= qpos[:, None], s, NEG)
        p = jax.nn.softmax(s, axis=-1)
        return jnp.einsum('bhqk,bkhd->bqhd', p.astype(v.dtype), v)

    out = lax.map(one, (qb, jnp.arange(nb)))
    return out.transpose(1, 0, 2, 3, 4).reshape(B, S, H, Dv)


def mla_mixer(c_q, c_kv, k_rope, q_norm_g, w_uq, kv_norm_g, w_ukv, cos, sin):
    B, S, _ = c_q.shape
    q = (rms_norm(c_q, q_norm_g) @ w_uq).reshape(B, S, MLA_HEADS, MLA_NOPE + MLA_ROPE)
    q = jnp.concatenate([q[..., :MLA_NOPE], apply_rope(q[..., MLA_NOPE:], cos, sin)], axis=-1)
    kv = (rms_norm(c_kv, kv_norm_g) @ w_ukv).reshape(B, S, MLA_HEADS, MLA_NOPE + MLA_V)
    k_pe = apply_rope(k_rope[:, :, None, :], cos, sin)
    k = jnp.concatenate([kv[..., :MLA_NOPE], jnp.broadcast_to(k_pe, (B, S, MLA_HEADS, MLA_ROPE))], axis=-1)
    v = kv[..., MLA_NOPE:]
    out = causal_block_attention(q, k, v, (MLA_NOPE + MLA_ROPE) ** -0.5)
    return out.reshape(B, S, MLA_W)


def causal_depthwise_conv(x, w, b):
    K = w.shape[0]
    y = lax.conv_general_dilated(x, w[:, None, :].astype(x.dtype), window_strides=(1,),
                                 padding=[(K - 1, 0)], dimension_numbers=('NWC', 'WIO', 'NWC'),
                                 feature_group_count=x.shape[-1])
    return y + b


def mlstm_mixer(q_pre, k_pre, v_in, o_pre, i_pre, f_pre, conv_w, conv_b, b_i, b_f):
    B, S, _ = v_in.shape
    f32 = jnp.float32
    qk = jax.nn.silu(causal_depthwise_conv(jnp.concatenate([q_pre, k_pre], axis=-1), conv_w, conv_b))
    q = qk[..., :ML_HEADS * ML_DK].reshape(B, S, ML_HEADS, ML_DK).astype(f32)
    k = qk[..., ML_HEADS * ML_DK:].reshape(B, S, ML_HEADS, ML_DK).astype(f32) * ML_DK ** -0.5
    v = v_in.reshape(B, S, ML_HEADS, ML_DV).astype(f32)
    log_i = (i_pre + b_i).astype(f32)
    log_f = jax.nn.log_sigmoid((f_pre + b_f).astype(f32))
    L = ML_CHUNK
    nc = S // L

    def to_chunks(a):
        return a.reshape(B, nc, L, ML_HEADS, -1).transpose(1, 0, 3, 2, 4)

    def gate_chunks(a):
        return a.reshape(B, nc, L, ML_HEADS).transpose(1, 0, 3, 2)

    causal = jnp.tril(jnp.ones((L, L), dtype=bool))

    def step(carry, inp):
        C, n, m = carry
        qc, kc, vc, li, lf = inp
        b = jnp.cumsum(lf, axis=-1)
        D = jnp.where(causal, b[..., :, None] - b[..., None, :] + li[..., None, :], NEG)
        inter = b + m[..., None]
        m_t = jnp.maximum(inter, jnp.max(D, axis=-1))
        w_intra = jnp.exp(D - m_t[..., None])
        w_inter = jnp.exp(inter - m_t)
        s = jnp.einsum('bhtd,bhsd->bhts', qc, kc) * w_intra
        num = jnp.einsum('bhts,bhsv->bhtv', s, vc) + w_inter[..., None] * jnp.einsum('bhtk,bhkv->bhtv', qc, C)
        nq = jnp.sum(s, axis=-1) + w_inter * jnp.einsum('bhtk,bhk->bht', qc, n)
        h = num / jnp.maximum(jnp.abs(nq), jnp.exp(-m_t))[..., None]
        bL = b[..., -1]
        g = bL[..., None] - b + li
        m_new = jnp.maximum(bL + m, jnp.max(g, axis=-1))
        decay = jnp.exp(bL + m - m_new)
        ws = jnp.exp(g - m_new[..., None])
        C = decay[..., None, None] * C + jnp.einsum('bhs,bhsk,bhsv->bhkv', ws, kc, vc)
        n = decay[..., None] * n + jnp.einsum('bhs,bhsk->bhk', ws, kc)
        return (C, n, m_new), h

    init = (jnp.zeros((B, ML_HEADS, ML_DK, ML_DV), f32),
            jnp.zeros((B, ML_HEADS, ML_DK), f32),
            jnp.full((B, ML_HEADS), NEG, f32))
    _, h = lax.scan(step, init, (to_chunks(q), to_chunks(k), to_chunks(v), gate_chunks(log_i), gate_chunks(log_f)))
    h = h.transpose(1, 0, 3, 2, 4).reshape(B, S, ML_W)
    return (jax.nn.sigmoid(o_pre.astype(f32)) * h).astype(v_in.dtype)


def dilated_branch(q, k, v, dil, n_back, scale):
    B, S, H, D = q.shape
    Ls = S // dil

    def sub(a):
        return a.reshape(B, Ls, dil, H, D).transpose(0, 2, 3, 1, 4)

    nb = -(-Ls // BLOCK)
    Lp = nb * BLOCK
    qs = jnp.pad(sub(q), ((0, 0), (0, 0), (0, 0), (0, Lp - Ls), (0, 0))).reshape(B, dil, H, nb, BLOCK, D)
    kpad = ((0, 0), (0, 0), (0, 0), (BLOCK, Lp - Ls), (0, 0))
    kp = jnp.pad(sub(k), kpad).reshape(B, dil, H, nb + 1, BLOCK, D)
    vp = jnp.pad(sub(v), kpad).reshape(B, dil, H, nb + 1, BLOCK, D)
    kw = jnp.concatenate([kp[:, :, :, :-1], kp[:, :, :, 1:]], axis=4)
    vw = jnp.concatenate([vp[:, :, :, :-1], vp[:, :, :, 1:]], axis=4)
    s = jnp.einsum('brhnqd,brhnkd->brhnqk', qs, kw, preferred_element_type=jnp.float32) * scale
    qi = jnp.arange(BLOCK)[:, None]
    kj = jnp.arange(2 * BLOCK)[None, :] - BLOCK
    dist = qi - kj
    kidx = jnp.arange(nb)[:, None, None] * BLOCK + kj[None]
    valid = ((dist >= 0) & (dist <= n_back))[None] & (kidx >= 0)
    s = jnp.where(valid, s, NEG)
    mx = jnp.max(s, axis=-1, keepdims=True)
    e = jnp.exp(s - mx)
    den = jnp.sum(e, axis=-1)
    o = jnp.einsum('brhnqk,brhnkd->brhnqd', e, vw.astype(jnp.float32)) / den[..., None]
    lse = mx[..., 0] + jnp.log(den)
    o = o.reshape(B, dil, H, Lp, D)[:, :, :, :Ls].transpose(0, 3, 1, 2, 4).reshape(B, S, H, D)
    lse = lse.reshape(B, dil, H, Lp)[..., :Ls].transpose(0, 3, 1, 2).reshape(B, S, H)
    return o, lse


def dilated_swa_mixer(q_in, k_in, v_in, cos, sin):
    B, S, _ = q_in.shape
    q = partial_rope(q_in.reshape(B, S, SW_HEADS, SW_HD), cos, sin)
    k = partial_rope(k_in.reshape(B, S, SW_HEADS, SW_HD), cos, sin)
    v = v_in.reshape(B, S, SW_HEADS, SW_HD)
    outs, lses = [], []
    for window, dil in SW_CONFIGS:
        o, lse = dilated_branch(q, k, v, dil, window // dil, SW_HD ** -0.5)
        outs.append(o)
        lses.append(lse)
    wts = jax.nn.softmax(jnp.stack(lses, axis=0), axis=0)
    out = jnp.einsum('gbsh,gbshd->bshd', wts, jnp.stack(outs, axis=0))
    return out.reshape(B, S, SW_W).astype(q_in.dtype)


def memory_cross_attention(h, mem_n, w_q, w_kv, w_o):
    B, S, _ = h.shape
    q = (h @ w_q).reshape(B, S, X_HEADS, X_HD)
    kv = (mem_n @ w_kv).reshape(B, mem_n.shape[1], 2, X_HEADS, X_HD)
    k, v = kv[:, :, 0], kv[:, :, 1]
    s = jnp.einsum('bshd,bmhd->bhsm', q, k, preferred_element_type=jnp.float32) * X_HD ** -0.5
    p = jax.nn.softmax(s, axis=-1)
    o = jnp.einsum('bhsm,bmhd->bshd', p.astype(v.dtype), v).reshape(B, S, D_MODEL)
    return o @ w_o


def swiglu(h, w_gate_up, w_down):
    g, u = jnp.split(h @ w_gate_up, 2, axis=-1)
    return (jax.nn.silu(g) * u) @ w_down


def setup_inputs(seed: int = 0) -> dict:
    key = jax.random.key(seed)
    ks = list(jax.random.split(key, 32))
    f32 = jnp.float32

    def w(shape, fan_in):
        return jax.random.normal(ks.pop(), shape, f32) * fan_in ** -0.5

    def gain(shape):
        return 1.0 + 0.02 * jax.random.normal(ks.pop(), shape, f32)

    def bias(shape, scale=0.01):
        return scale * jax.random.normal(ks.pop(), shape, f32)

    return {
        "x": jax.random.normal(ks.pop(), (BATCH, SEQ, D_MODEL), f32),
        "mem": jax.random.normal(ks.pop(), (BATCH, N_MEM, D_MODEL), f32),
        "w_in": w((DEPTH, D_MODEL, D_IN), D_MODEL),
        "mla_q_norm": gain((DEPTH, MLA_Q_LORA)),
        "mla_w_uq": w((DEPTH, MLA_Q_LORA, MLA_HEADS * (MLA_NOPE + MLA_ROPE)), MLA_Q_LORA),
        "mla_kv_norm": gain((DEPTH, MLA_KV_LORA)),
        "mla_w_ukv": w((DEPTH, MLA_KV_LORA, MLA_HEADS * (MLA_NOPE + MLA_V)), MLA_KV_LORA),
        "ml_conv_w": w((DEPTH, ML_CONV, 2 * ML_HEADS * ML_DK), ML_CONV),
        "ml_conv_b": bias((DEPTH, 2 * ML_HEADS * ML_DK)),
        "ml_b_i": bias((DEPTH, ML_HEADS), 0.1),
        "ml_b_f": jnp.linspace(3.0, 6.0, ML_HEADS, dtype=f32)[None, :] + bias((DEPTH, ML_HEADS)),
        "w_out": w((DEPTH, D_MIX, D_MODEL), D_MIX),
        "x_w_q": w((DEPTH, D_MODEL, D_MODEL), D_MODEL),
        "x_w_kv": w((DEPTH, D_MODEL, 2 * D_MODEL), D_MODEL),
        "x_w_o": w((DEPTH, D_MODEL, D_MODEL), D_MODEL),
        "w_gate_up": w((DEPTH, D_MODEL, 2 * D_FF), D_MODEL),
        "w_down": w((DEPTH, D_FF, D_MODEL), D_FF),
        "norm_mix_pre": gain((DEPTH, D_MODEL)),
        "norm_mix_post": gain((DEPTH, D_MODEL)),
        "norm_mem": gain((DEPTH, D_MODEL)),
        "norm_x_pre": gain((DEPTH, D_MODEL)),
        "norm_x_post": gain((DEPTH, D_MODEL)),
        "norm_ffn_pre": gain((DEPTH, D_MODEL)),
        "norm_ffn_post": gain((DEPTH, D_MODEL)),
    }


def reference(x, mem, w_in, mla_q_norm, mla_w_uq, mla_kv_norm, mla_w_ukv, ml_conv_w, ml_conv_b,
              ml_b_i, ml_b_f, w_out, x_w_q, x_w_kv, x_w_o, w_gate_up, w_down,
              norm_mix_pre, norm_mix_post, norm_mem, norm_x_pre, norm_x_post, norm_ffn_pre, norm_ffn_post):
    S = x.shape[1]
    cos_mla, sin_mla = rope_tables(S, MLA_ROPE)
    cos_sw, sin_sw = rope_tables(S, SW_ROT)
    splits = np.cumsum(IN_SIZES)[:-1].tolist()
    for l in range(DEPTH):
        h = rms_norm(x, norm_mix_pre[l])
        (c_q, c_kv, k_rope, ml_q, ml_k, ml_v, ml_o, ml_i, ml_f,
         sw_q, sw_k, sw_v) = jnp.split(h @ w_in[l], splits, axis=-1)
        y_a = mla_mixer(c_q, c_kv, k_rope, mla_q_norm[l], mla_w_uq[l], mla_kv_norm[l], mla_w_ukv[l],
                        cos_mla, sin_mla)
        y_b = mlstm_mixer(ml_q, ml_k, ml_v, ml_o, ml_i, ml_f, ml_conv_w[l], ml_conv_b[l], ml_b_i[l], ml_b_f[l])
        y_c = dilated_swa_mixer(sw_q, sw_k, sw_v, cos_sw, sin_sw)
        y = jnp.concatenate([y_a, y_b, y_c], axis=-1) @ w_out[l]
        x = x + rms_norm(y, norm_mix_post[l])
        h = rms_norm(x, norm_x_pre[l])
        y = memory_cross_attention(h, rms_norm(mem, norm_mem[l]), x_w_q[l], x_w_kv[l], x_w_o[l])
        x = x + rms_norm(y, norm_x_post[l])
        h = rms_norm(x, norm_ffn_pre[l])
        y = swiglu(h, w_gate_up[l], w_down[l])
        x = x + rms_norm(y, norm_ffn_post[l])
    return x
```

```cpp
#include <hip/hip_runtime.h>
#include <cstdio>
#include <cstdint>

#define LAS __attribute__((address_space(3)))
#define GAS __attribute__((address_space(1)))
typedef unsigned short bf16_t;
typedef short bf16x8 __attribute__((ext_vector_type(8)));
typedef short s16x4 __attribute__((ext_vector_type(4)));
typedef float f32x2 __attribute__((ext_vector_type(2)));
typedef float f32x4 __attribute__((ext_vector_type(4)));
typedef float f32x16 __attribute__((ext_vector_type(16)));
typedef unsigned u32x2 __attribute__((ext_vector_type(2)));
typedef unsigned u32x4 __attribute__((ext_vector_type(4)));
typedef GAS unsigned gu32;

constexpr int DM = 1024, NB = 2, SEQ = 16384, DEPTH = 4, T = NB * SEQ, NMEM = 256;
constexpr int D_IN = 2216, D_INP = 2304, D_FF = 2816;
constexpr float EPS = 1e-6f;
constexpr float LOG2E = 1.4426950408889634f;
constexpr int C_CQ = 0, C_CKV = 256, C_KR = 384, C_GATE = 416, C_MLQ = 512, C_MLK = 768, C_MLV = 1024, C_MLO = 1280, C_SWQ = 1536, C_SWK = 1792, C_SWV = 2048;
__host__ __device__ __forceinline__ int win_src_col(int n) {
    if (n < 384) return n;
    if (n < 416) { const int c = n - 384; return 384 + 16 * ((c >> 2) & 1) + 4 * (c >> 3) + (c & 3); }
    if (n < 424) return 1440 + (n - 416);
    if (n < 512) return -1;
    if (n < 1536) return 416 + (n - 512);
    if (n < 2048) { const int m = n - 1536, t = m >> 8, hh = (m >> 6) & 3, c = m & 63; const int dim = c < 16 ? 8 * ((c >> 2) & 1) + 4 * (c >> 3) + (c & 3) : c; return 1448 + t * 256 + hh * 64 + dim; }
    return 1960 + (n - 2048);
}

constexpr size_t MiB = 1u << 20;
constexpr size_t WS_CTL = 0, CTL_ZERO_BYTES = 64 * 1024;
constexpr size_t WS_TMC = 1 * MiB, WS_TMS = 2 * MiB, WS_TSC = 3 * MiB, WS_TSS = 3 * MiB + 512 * 1024;
constexpr size_t WS_WIN = 4 * MiB;
constexpr size_t WS_WUQ = WS_WIN + (size_t)D_INP * 1024 * 2;
constexpr size_t WS_WUKV = WS_WUQ + 768 * 256 * 2;
constexpr size_t WS_WOUT = WS_WUKV + 1024 * 128 * 2;
constexpr size_t WS_WQK = WS_WOUT + 2 * MiB;
constexpr size_t WS_WVO = WS_WQK + 4 * MiB;
static_assert(WS_WVO + 4 * MiB <= 20 * MiB, "attention-side weights");
constexpr size_t WS_WGU = 20 * MiB;
constexpr size_t WS_WDN = WS_WGU + 11 * MiB;
static_assert(WS_WDN + (size_t)1024 * 2816 * 2 <= 40 * MiB, "ffn weights");
constexpr size_t WS_MEMK = 490 * MiB;
constexpr size_t WS_MEMV = 494 * MiB;
constexpr size_t WS_WXQR = 498 * MiB;
constexpr size_t WS_WXOT = 500 * MiB;
constexpr size_t WS_KPE = 40 * MiB;
constexpr size_t WS_GATE = 42 * MiB;
constexpr size_t WS_MLB = 43 * MiB;
constexpr size_t WS_MLM = 43 * MiB + 16 * 1024;
constexpr size_t WS_RSTD = 43 * MiB + 64 * 1024;
constexpr size_t WS_MLU = 44 * MiB;
constexpr size_t WS_MLC = 61 * MiB;
constexpr size_t WS_MLN = 69 * MiB;
constexpr size_t WS_SWL = 70 * MiB;
constexpr size_t WS_H = 72 * MiB;
constexpr size_t WS_BIG = 136 * MiB;
constexpr size_t WS_PROJ = WS_BIG;
constexpr size_t WS_Q = 280 * MiB;
constexpr size_t WS_KV = 328 * MiB;
constexpr size_t WS_MLQK = 392 * MiB;
constexpr size_t WS_SWO = 424 * MiB;
constexpr size_t WS_Y = WS_BIG;
constexpr size_t WS_P = 264 * MiB;
constexpr size_t WS_ACT = 200 * MiB;
constexpr size_t WS_WXKVT = WS_BIG;
constexpr size_t WS_MEMN = WS_BIG + 16 * MiB;
constexpr size_t WS_SSQ = 472 * MiB;
constexpr size_t WS_SL = 473 * MiB;
constexpr size_t WS_XS = 473 * MiB + 512 * 1024;
constexpr size_t WS_CNT = 32 * 1024;
constexpr size_t WS_W2ND = 474 * MiB;
constexpr size_t WDELTA = WS_W2ND - WS_WIN;
constexpr size_t WS_END = 502 * MiB;
static_assert(WS_ACT + (size_t)T * D_FF * 2 <= WS_END, "act");

constexpr int RING_BYTES = 131072;
constexpr int XCH_OFF = RING_BYTES;
constexpr int MISC_OFF = XCH_OFF + 8192;
constexpr int LDS_BYTES = 147456;
constexpr int NWAVES = 8;

__device__ __forceinline__ unsigned cvt_pk_bf16(float lo, float hi) { unsigned r; asm volatile("v_cvt_pk_bf16_f32 %0, %1, %2" : "=v"(r) : "v"(lo), "v"(hi)); return r; }
__device__ __forceinline__ float bf2f(unsigned short b) { return __uint_as_float(((unsigned)b) << 16); }
__device__ __forceinline__ float bflo(unsigned w) { return __uint_as_float(w << 16); }
__device__ __forceinline__ float bfhi(unsigned w) { return __uint_as_float(w & 0xffff0000u); }
__device__ __forceinline__ bf16_t f2bf(float f) { return (bf16_t)(cvt_pk_bf16(f, 0.f) & 0xffffu); }
__device__ __forceinline__ void unpack8(const u32x4 w, float (&v)[8]) { v[0] = bflo(w.x); v[1] = bfhi(w.x); v[2] = bflo(w.y); v[3] = bfhi(w.y); v[4] = bflo(w.z); v[5] = bfhi(w.z); v[6] = bflo(w.w); v[7] = bfhi(w.w); }
__device__ __forceinline__ u32x4 pack8(const float (&v)[8]) { u32x4 w; w.x = cvt_pk_bf16(v[0], v[1]); w.y = cvt_pk_bf16(v[2], v[3]); w.z = cvt_pk_bf16(v[4], v[5]); w.w = cvt_pk_bf16(v[6], v[7]); return w; }
__device__ __forceinline__ float wave_sum(float v) {
#pragma unroll
    for (int o = 1; o < 64; o <<= 1) v += __shfl_xor(v, o);
    return v;
}
__device__ __forceinline__ float fexp2(float x) { return __builtin_amdgcn_exp2f(x); }
__device__ __forceinline__ float flog2(float x) { return __builtin_amdgcn_logf(x); }
__device__ __forceinline__ float frcp(float x) { return __builtin_amdgcn_rcpf(x); }
__device__ __forceinline__ int crow(int reg, int hi) { return (reg & 3) + 8 * (reg >> 2) + 4 * hi; }
__device__ __forceinline__ int hw_lane() { int l; asm volatile("v_mbcnt_lo_u32_b32 %0, -1, 0\n\tv_mbcnt_hi_u32_b32 %0, -1, %0" : "=v"(l)); return l; }
#define LDS_WAIT() asm volatile("s_waitcnt lgkmcnt(0)" ::: "memory")
#define VM_WAIT() asm volatile("s_waitcnt vmcnt(0)" ::: "memory")
__device__ __forceinline__ s16x4 tr_read(const LAS unsigned char* p) {
    typedef short v4i16_t __attribute__((ext_vector_type(4)));
    return __builtin_bit_cast(s16x4, __builtin_amdgcn_ds_read_tr16_b64_v4i16((LAS v4i16_t*)p));
}
__device__ __forceinline__ bf16x8 cat4(s16x4 a, s16x4 b) { return (bf16x8){a[0], a[1], a[2], a[3], b[0], b[1], b[2], b[3]}; }

#define XB_TMO      128
#define XB_XCNT(j)  (256  + 64 * (j))
#define XB_XSUB(j)  (1280 + 64 * (j))
#define XB_XGEN(j)  (2304 + 64 * (j))
#define XB_TOP      3328
#define XB_TOPGEN   3392
#define XCD_BAR_WORDS 3456
#define XB_SPIN_CAP (1u << 22)
__device__ __forceinline__ unsigned xb_ld(unsigned* p)              { return __hip_atomic_load(p, __ATOMIC_RELAXED, __HIP_MEMORY_SCOPE_AGENT); }
__device__ __forceinline__ unsigned xb_add(unsigned* p, unsigned v) { return __hip_atomic_fetch_add(p, v, __ATOMIC_RELAXED, __HIP_MEMORY_SCOPE_AGENT); }
__device__ __forceinline__ unsigned xb_xcc_id() { return (unsigned)__builtin_amdgcn_s_getreg((3 << 11) | 20) & 0xFu; }
#define XB_SPIN(cond, bar) do { unsigned _sp = 0; while (cond) { __builtin_amdgcn_s_sleep(1); \
    if ((++_sp & 255u) == 0u) { if (xb_ld(&(bar)[XB_TMO])) break; if (_sp > XB_SPIN_CAP) { atomicAdd(&(bar)[XB_TMO], 1u); break; } } } } while (0)
struct XcdBarrier { unsigned* bar; unsigned x; volatile LAS unsigned* st; int wave0; };
__device__ __forceinline__ XcdBarrier xcd_barrier_post(unsigned* bar, volatile LAS unsigned* st) {
    XcdBarrier b; b.bar = bar; b.x = xb_xcc_id(); b.st = st;
    if (threadIdx.x == 0) (void)xb_add(&bar[XB_XCNT(b.x)], 1u);
    return b;
}
__device__ __forceinline__ void xcd_barrier_complete(unsigned* bar, unsigned x, unsigned& nloc, unsigned& nx) {
    const unsigned G = gridDim.x * gridDim.y * gridDim.z;
    unsigned sum, cnt, mine, sp = 0u;
    for (;;) {
        sum = 0u; cnt = 0u; mine = 0u;
#pragma unroll
        for (unsigned j = 0; j < 16; ++j) { const unsigned c = xb_ld(&bar[XB_XCNT(j)]); sum += c; cnt += (c > 0u) ? 1u : 0u; mine = (j == x) ? c : mine; }
        if (sum == G) break;
        __builtin_amdgcn_s_sleep(1);
        if ((++sp & 255u) == 0u) { if (xb_ld(&bar[XB_TMO])) break; if (sp > XB_SPIN_CAP) { atomicAdd(&bar[XB_TMO], 1u); break; } }
    }
    nloc = mine > 0u ? mine : 1u; nx = cnt > 0u ? cnt : 1u;
}
__device__ __forceinline__ void xcd_barrier(const XcdBarrier& b) {
    asm volatile("s_waitcnt vmcnt(0)" ::: "memory");
    __syncthreads();
    if (b.wave0 == 0 && hw_lane() == 0) {
        unsigned* bar = b.bar;
        __builtin_amdgcn_s_waitcnt(0);
        unsigned nloc = b.st[0], nx = b.st[1];
        if (nloc == 0u) { xcd_barrier_complete(bar, b.x, nloc, nx); b.st[0] = nloc; b.st[1] = nx; }
        const unsigned old = xb_add(&bar[XB_XSUB(b.x)], 1u);
        const unsigned gen = old / nloc;
        if (old + 1u == (gen + 1u) * nloc) {
            __builtin_amdgcn_fence(__ATOMIC_RELEASE, "agent");
            asm volatile("s_waitcnt vmcnt(0)" ::: "memory");
            const unsigned og = xb_add(&bar[XB_TOP], 1u);
            const unsigned tg = og / nx;
            if (og + 1u == (tg + 1u) * nx) xb_add(&bar[XB_TOPGEN], 1u);
            else XB_SPIN(xb_ld(&bar[XB_TOPGEN]) == tg, bar);
            __builtin_amdgcn_fence(__ATOMIC_ACQUIRE, "agent");
            xb_add(&bar[XB_XGEN(b.x)], 1u);
            asm volatile("s_waitcnt vmcnt(0)" ::: "memory");
        } else {
            XB_SPIN(xb_ld(&bar[XB_XGEN(b.x)]) == gen, bar);
            __builtin_amdgcn_fence(__ATOMIC_ACQUIRE, "agent");
            asm volatile("s_waitcnt vmcnt(0)" ::: "memory");
        }
    }
    __syncthreads();
}

namespace pg8 {
constexpr int BM = 256, BK = 64, HALF = 128, HTB = HALF * BK * 2, STAGE_BYTES = 8 * HTB, NXCD = 8, WGM = 8;
__host__ __device__ __forceinline__ int lds_byte(int r, int c) { const int st = (r >> 4) * 2 + (c >> 5), rr = r & 15, cc = c & 31, ob = rr * 64 + cc * 2; return st * 1024 + (ob ^ (((ob >> 9) & 1) << 5)); }
__host__ __device__ __forceinline__ void stage_rc(int b, int& R, int& C) { const int st = b / 1024, sb = b % 1024, swz = sb ^ (((sb >> 9) & 1) << 5); R = (st >> 1) * 16 + swz / 64; C = (st & 1) * 32 + (swz % 64) / 2; }
__host__ __device__ __forceinline__ int perm32(int rho) { const int n = rho >> 4, i = rho & 15; return 8 * (i >> 2) + 4 * n + (i & 3); }

struct Unit { int pm, pn; size_t aoff, boff; };
struct Gemm { const bf16_t* A; const bf16_t* Bt; int lda, ldb, K; };

__device__ __forceinline__ int xcd_remap(int wgid, int nwg) { const int q = nwg / NXCD, r = nwg % NXCD, xcd = wgid % NXCD, off = wgid / NXCD; return (xcd < r ? xcd * (q + 1) : r * (q + 1) + (xcd - r) * q) + off; }

template <int MODE> struct Order {
    int nM, nN, nwg, G, c, lda, ldb;
    __device__ __forceinline__ void init(int nM_, int nN_, int G_, int c_, int lda_, int ldb_) { nM = nM_; nN = nN_; nwg = nM_ * nN_; G = G_; c = c_; lda = lda_; ldb = ldb_; }
    __device__ __forceinline__ bool next(int i, Unit& u) const {
        const long L = (long)i * G + c; if (L >= nwg) return false;
        const int wgid = xcd_remap((int)L, nwg);
        if (MODE == 0) {
            const int nig = WGM * nN, gid = wgid / nig, fm = gid * WGM, gsz = (nM - fm) < WGM ? (nM - fm) : WGM;
            u.pm = fm + ((wgid % nig) % gsz); u.pn = (wgid % nig) / gsz;
            u.aoff = (size_t)u.pm * BM * lda * 2; u.boff = (size_t)u.pn * BM * ldb * 2;
        } else if (MODE == 1 || MODE == 2) {
            const int bh = wgid >> 6, rt = wgid & 63, b = bh >> 2, h = bh & 3;
            u.pm = b * 64 + rt; u.pn = h;
            u.aoff = ((size_t)u.pm * BM * lda + h * 256) * 2;
            u.boff = (MODE == 1) ? ((size_t)(b * 256) * 1024 + h * 256) * 2 : ((size_t)(b * 1024 + h * 256) * 256) * 2;
        } else if (MODE == 3) {
            u.pm = wgid >> 2; u.pn = wgid & 3;
            u.aoff = (size_t)u.pm * BM * 1024 * 2; u.boff = ((size_t)(u.pm >> 1) * 2048 * 1024 + (size_t)u.pn * BM * 1024) * 2;
        } else if (MODE == 4) {
            u.pm = wgid >> 2; u.pn = wgid & 3;
            u.aoff = (size_t)u.pm * BM * 1024 * 2; u.boff = ((size_t)(u.pm >> 1) * 2048 * 1024 + (size_t)(1024 + u.pn * BM) * 1024) * 2;
        } else if (MODE == 5) {
            const int nig = WGM * nN, gid = wgid / nig, fm = gid * WGM, gsz = (nM - fm) < WGM ? (nM - fm) : WGM;
            u.pm = fm + ((wgid % nig) % gsz); u.pn = (wgid % nig) / gsz;
            u.aoff = (size_t)u.pm * BM * lda * 2; u.boff = ((size_t)(u.pm >> 6) * 1024 + (size_t)u.pn * BM) * ldb * 2;
        } else if (MODE == 6) {
            const int bh = wgid >> 2, ct = wgid & 3, b = bh >> 2, h = bh & 3;
            u.pm = bh; u.pn = ct;
            u.aoff = ((size_t)(b * 256) * 1024 + h * 256) * 2; u.boff = ((size_t)(ct * 256) * 1024 + h * 256) * 2;
        } else {
            const int b = wgid >> 4, h = (wgid >> 2) & 3, rt = wgid & 3;
            u.pm = b * 4 + rt; u.pn = h;
            u.aoff = ((size_t)(rt * 256) * 1024 + h * 256) * 2; u.boff = ((size_t)(b * 256) * 1024 + h * 256) * 2;
        }
        return true;
    }
};

__device__ __forceinline__ float rstd4(const float* p) { const f32x4 v = *(const f32x4*)p; return __builtin_amdgcn_rsqf(((v[0] + v[1]) + (v[2] + v[3])) * (1.0f / DM) + EPS); }
template <int RS> struct EpiStoreT {
    static constexpr bool PERM = true;
    bf16_t* O; int ldc; const float* rs;
    __device__ __forceinline__ void operator()(f32x4 (&acc)[2][2][4][2], const Unit& u, int wr, int wc, int fr, int fq, LAS unsigned char* xch) const {
        const int row0 = u.pm * BM + wr * 64 + fr, col0 = u.pn * BM + wc * 32 + 8 * fq;
#pragma unroll
        for (int ai = 0; ai < 2; ++ai)
#pragma unroll
            for (int m = 0; m < 4; ++m) { bf16_t* rowp = O + (size_t)(row0 + ai * HALF + m * 16) * ldc + col0; float sc = 1.0f;
                if (RS == 0) asm volatile("" : "+v"(sc));
                if (RS == 1) sc = rstd4(rs + (size_t)(row0 + ai * HALF + m * 16) * 4);
                if (RS == 2) { const f32x4 p4 = *(const f32x4*)(rs + (size_t)(row0 + ai * HALF + m * 16) * 8 + 4); sc = __builtin_amdgcn_rsqf(((p4[0] + p4[1]) + (p4[2] + p4[3])) * (1.0f / 128.f) + EPS); }
#pragma unroll
                for (int bj = 0; bj < 2; ++bj) { const f32x4 v0 = acc[ai][bj][m][0] * sc, v1 = acc[ai][bj][m][1] * sc;
                    u32x4 w; w.x = cvt_pk_bf16(v0[0], v0[1]); w.y = cvt_pk_bf16(v0[2], v0[3]); w.z = cvt_pk_bf16(v1[0], v1[1]); w.w = cvt_pk_bf16(v1[2], v1[3]);
                    *(u32x4*)(rowp + bj * HALF) = w; } }
    }
};
typedef EpiStoreT<0> EpiStore;
typedef EpiStoreT<1> EpiStoreRS;
typedef EpiStoreT<2> EpiStoreKV;
struct EpiQ {
    static constexpr bool PERM = false;
    bf16_t* O; const float* tcos; const float* tsin; float scale; const float* ssq;
    __device__ __forceinline__ void operator()(f32x4 (&acc)[2][2][4][2], const Unit& u, int wr, int wc, int fr, int fq, LAS unsigned char* xch) const {
#pragma unroll
        for (int ai = 0; ai < 2; ++ai)
#pragma unroll
            for (int m = 0; m < 4; ++m) {
                const int row = u.pm * BM + ai * HALF + wr * 64 + m * 16 + fr, pos = row & (SEQ - 1);
                const f32x4 p4 = *(const f32x4*)(ssq + (size_t)row * 8); const float rsc = scale * __builtin_amdgcn_rsqf(((p4[0] + p4[1]) + (p4[2] + p4[3])) * (1.0f / 256.f) + EPS);
#pragma unroll
                for (int bj = 0; bj < 2; ++bj) {
                    const int g = 8 * u.pn + 4 * bj + wc;
                    f32x4 x1 = acc[ai][bj][m][0], x2 = acc[ai][bj][m][1];
                    if ((g % 3) == 2) {
                        const f32x4 c = *(const f32x4*)(tcos + pos * 16 + 4 * fq), s = *(const f32x4*)(tsin + pos * 16 + 4 * fq);
                        const f32x4 o1 = x1 * c - x2 * s, o2 = x2 * c + x1 * s; x1 = o1; x2 = o2;
                    }
                    x1 = x1 * rsc; x2 = x2 * rsc;
                    bf16_t* p = O + (size_t)row * 768 + g * 32 + 4 * fq;
                    u32x2 w1, w2; w1.x = cvt_pk_bf16(x1[0], x1[1]); w1.y = cvt_pk_bf16(x1[2], x1[3]); w2.x = cvt_pk_bf16(x2[0], x2[1]); w2.y = cvt_pk_bf16(x2[2], x2[3]);
                    *(u32x2*)p = w1; *(u32x2*)(p + 16) = w2;
                }
            }
    }
};
struct EpiSwiGLU {
    static constexpr bool PERM = true;
    bf16_t* O; const float* rs;
    __device__ __forceinline__ void operator()(f32x4 (&acc)[2][2][4][2], const Unit& u, int wr, int wc, int fr, int fq, LAS unsigned char* xch) const {
        const int row0 = u.pm * BM + wr * 64 + fr, col0 = u.pn * HALF + wc * 32 + 8 * fq;
#pragma unroll
        for (int ai = 0; ai < 2; ++ai)
#pragma unroll
            for (int m = 0; m < 4; ++m) {
                float a[8]; const float sc = rstd4(rs + (size_t)(row0 + ai * HALF + m * 16) * 4);
#pragma unroll
                for (int n = 0; n < 2; ++n)
#pragma unroll
                    for (int j = 0; j < 4; ++j) { const float g = acc[ai][0][m][n][j] * sc, up = acc[ai][1][m][n][j] * sc; a[n * 4 + j] = g * frcp(1.f + fexp2(-g * LOG2E)) * up; }
                u32x4 w; w.x = cvt_pk_bf16(a[0], a[1]); w.y = cvt_pk_bf16(a[2], a[3]); w.z = cvt_pk_bf16(a[4], a[5]); w.w = cvt_pk_bf16(a[6], a[7]);
                *(u32x4*)(O + (size_t)(row0 + ai * HALF + m * 16) * D_FF + col0) = w;
            }
    }
};
struct EpiProj {
    static constexpr bool PERM = true;
    bf16_t* O; const float* rs; bf16_t* KPE; float* GATE; float* SSQ; const float* tmc; const float* tms; const float* tsc; const float* tss; const float* bi; const float* bf; float qs;
    __device__ __forceinline__ void operator()(f32x4 (&acc)[2][2][4][2], const Unit& u, int wr, int wc, int fr, int fq, LAS unsigned char* xch) const {
        const int row0 = u.pm * BM + wr * 64 + fr, col0 = u.pn * BM + wc * 32 + 8 * fq, pn = u.pn;
#pragma unroll
        for (int ai = 0; ai < 2; ++ai)
#pragma unroll
            for (int m = 0; m < 4; ++m) {
                const int row = row0 + ai * HALF + m * 16, pos = row & (SEQ - 1); const float sc = rstd4(rs + (size_t)row * 4);
                bf16_t* rowp = O + (size_t)row * D_INP + col0;
                f32x4 v[2][2];
#pragma unroll
                for (int bj = 0; bj < 2; ++bj) { v[bj][0] = acc[ai][bj][m][0] * sc; v[bj][1] = acc[ai][bj][m][1] * sc; }
                if (pn <= 1) {
                    float ss = 0.f;
#pragma unroll
                    for (int bj = 0; bj < 2; ++bj) if (pn == 0 || bj == 0) {
#pragma unroll
                        for (int n = 0; n < 2; ++n) ss += (v[bj][n][0] * v[bj][n][0] + v[bj][n][1] * v[bj][n][1]) + (v[bj][n][2] * v[bj][n][2] + v[bj][n][3] * v[bj][n][3]); }
                    ss += __shfl_xor(ss, 16); ss += __shfl_xor(ss, 32);
                    if (fq == 0) SSQ[(size_t)row * 8 + 4 * pn + wc] = ss;
                }
                if (pn == 1) {
                    if (wc == 0) {
                        const f32x4 c = *(const f32x4*)(tmc + pos * 16 + 4 * fq), s = *(const f32x4*)(tms + pos * 16 + 4 * fq);
                        const f32x4 o1 = v[1][0] * c - v[1][1] * s, o2 = v[1][1] * c + v[1][0] * s;
                        u32x2 w1, w2; w1.x = cvt_pk_bf16(o1[0], o1[1]); w1.y = cvt_pk_bf16(o1[2], o1[3]); w2.x = cvt_pk_bf16(o2[0], o2[1]); w2.y = cvt_pk_bf16(o2[2], o2[3]);
                        *(u32x2*)(KPE + (size_t)row * 32 + 4 * fq) = w1; *(u32x2*)(KPE + (size_t)row * 32 + 16 + 4 * fq) = w2;
                    } else if (wc == 1 && fq == 0) {
                        f32x4 li, lf;
#pragma unroll
                        for (int j = 0; j < 4; ++j) { li[j] = v[1][0][j] + bi[j]; const float z = v[1][1][j] + bf[j]; lf[j] = fminf(z, 0.f) - log1pf(expf(-fabsf(z))); }
                        *(f32x4*)(GATE + (size_t)row * 8) = li; *(f32x4*)(GATE + (size_t)row * 8 + 4) = lf;
                    }
                }
                if (pn == 6 || pn == 7) {
                    if ((wc & 1) == 0 && fq < 2) {
                        const f32x4 c = *(const f32x4*)(tsc + pos * 8 + 4 * fq), s = *(const f32x4*)(tss + pos * 8 + 4 * fq);
#pragma unroll
                        for (int bj = 0; bj < 2; ++bj) { const f32x4 o1 = v[bj][0] * c - v[bj][1] * s, o2 = v[bj][1] * c + v[bj][0] * s; v[bj][0] = o1; v[bj][1] = o2; }
                    }
                    if (pn == 6) {
#pragma unroll
                        for (int bj = 0; bj < 2; ++bj) { v[bj][0] = v[bj][0] * qs; v[bj][1] = v[bj][1] * qs; } }
                }
#pragma unroll
                for (int bj = 0; bj < 2; ++bj) {
                    if (pn == 1 && bj == 1) continue;
                    u32x4 w; w.x = cvt_pk_bf16(v[bj][0][0], v[bj][0][1]); w.y = cvt_pk_bf16(v[bj][0][2], v[bj][0][3]); w.z = cvt_pk_bf16(v[bj][1][0], v[bj][1][1]); w.w = cvt_pk_bf16(v[bj][1][2], v[bj][1][3]);
                    *(u32x4*)(rowp + bj * HALF) = w; }
            }
    }
};
template <bool LAST> struct EpiResidual {
    static constexpr bool PERM = true;
    bf16_t* XB; float* OUT; const float* g; float* SL; float* XS; unsigned* cnt; unsigned target; const bf16_t* XBld = nullptr;
    __device__ __forceinline__ void operator()(f32x4 (&acc)[2][2][4][2], const Unit& u, int wr, int wc, int fr_, int fq_, LAS unsigned char* xch) const {
        LAS float* XP = (LAS float*)xch; LAS float* RS = (LAS float*)(xch + 4096);
        int fr = fr_, fq = fq_; asm volatile("" : "+v"(fr), "+v"(fq));
        const int t = (wr * 4 + wc) * 64 + fq * 16 + fr;
        const int col0 = u.pn * BM + wc * 32 + 8 * fq;
        u32x4 xw[2][4][2];
#pragma unroll
        for (int ai = 0; ai < 2; ++ai)
#pragma unroll
            for (int m = 0; m < 4; ++m)
#pragma unroll
                for (int bj = 0; bj < 2; ++bj) xw[ai][m][bj] = *(const u32x4*)((XBld ? XBld : XB) + ((size_t)u.pm * BM + ai * HALF + wr * 64 + m * 16 + fr) * DM + col0 + bj * HALF);
#pragma unroll
        for (int ai = 0; ai < 2; ++ai)
#pragma unroll
            for (int m = 0; m < 4; ++m) { float ss = 0.f;
#pragma unroll
                for (int bj = 0; bj < 2; ++bj)
#pragma unroll
                    for (int n = 0; n < 2; ++n) { const f32x4 v = acc[ai][bj][m][n]; ss += (v[0] * v[0] + v[1] * v[1]) + (v[2] * v[2] + v[3] * v[3]); }
                ss += __shfl_xor(ss, 16); ss += __shfl_xor(ss, 32);
                if (fq == 0) XP[(ai * HALF + wr * 64 + m * 16 + fr) * 4 + wc] = ss; }
        asm volatile("s_waitcnt lgkmcnt(0)" ::: "memory"); __builtin_amdgcn_s_barrier(); asm volatile("" ::: "memory");
        if (t < 256) { const f32x4 p4 = *(const LAS f32x4*)(XP + t * 4);
            __hip_atomic_store((unsigned*)(SL + ((size_t)u.pm * BM + t) * 4 + u.pn), __float_as_uint((p4[0] + p4[1]) + (p4[2] + p4[3])), __ATOMIC_RELAXED, __HIP_MEMORY_SCOPE_AGENT); }
        asm volatile("s_waitcnt vmcnt(0)" ::: "memory"); __builtin_amdgcn_s_barrier(); asm volatile("" ::: "memory");
        if (t == 0) { unsigned* c = cnt + u.pm * 16; (void)__hip_atomic_fetch_add(c, 1u, __ATOMIC_RELAXED, __HIP_MEMORY_SCOPE_AGENT);
            unsigned sp = 0; while (__hip_atomic_load(c, __ATOMIC_RELAXED, __HIP_MEMORY_SCOPE_AGENT) < target) { __builtin_amdgcn_s_sleep(1); if (++sp > (1u << 22)) break; } }
        asm volatile("s_waitcnt vmcnt(0) lgkmcnt(0)" ::: "memory"); __builtin_amdgcn_s_barrier(); asm volatile("" ::: "memory");
        if (t < 256) { const unsigned* s4 = (const unsigned*)(SL + ((size_t)u.pm * BM + t) * 4);
            const float a = __uint_as_float(__hip_atomic_load(s4 + 0, __ATOMIC_RELAXED, __HIP_MEMORY_SCOPE_AGENT)), b = __uint_as_float(__hip_atomic_load(s4 + 1, __ATOMIC_RELAXED, __HIP_MEMORY_SCOPE_AGENT)),
                        c = __uint_as_float(__hip_atomic_load(s4 + 2, __ATOMIC_RELAXED, __HIP_MEMORY_SCOPE_AGENT)), d = __uint_as_float(__hip_atomic_load(s4 + 3, __ATOMIC_RELAXED, __HIP_MEMORY_SCOPE_AGENT));
            RS[t] = __builtin_amdgcn_rsqf(((a + b) + (c + d)) * (1.0f / DM) + EPS); }
        asm volatile("s_waitcnt vmcnt(0) lgkmcnt(0)" ::: "memory"); __builtin_amdgcn_s_barrier(); asm volatile("" ::: "memory");
        f32x4 gv[2][2];
#pragma unroll
        for (int bj = 0; bj < 2; ++bj) { gv[bj][0] = *(const f32x4*)(g + col0 + bj * HALF); gv[bj][1] = *(const f32x4*)(g + col0 + bj * HALF + 4); }
#pragma unroll
        for (int ai = 0; ai < 2; ++ai)
#pragma unroll
            for (int m = 0; m < 4; ++m) {
                const int rl = ai * HALF + wr * 64 + m * 16 + fr; const size_t grow = (size_t)u.pm * BM + rl; const float rstd = RS[rl]; float ss2 = 0.f;
#pragma unroll
                for (int bj = 0; bj < 2; ++bj) {
                    float x[8]; unpack8(xw[ai][m][bj], x);
                    const f32x4 y0 = acc[ai][bj][m][0] * rstd * gv[bj][0], y1 = acc[ai][bj][m][1] * rstd * gv[bj][1];
                    x[0] += y0[0]; x[1] += y0[1]; x[2] += y0[2]; x[3] += y0[3]; x[4] += y1[0]; x[5] += y1[1]; x[6] += y1[2]; x[7] += y1[3];
                    if (LAST) { float* po = OUT + grow * DM + col0 + bj * HALF; *(f32x4*)po = (f32x4){x[0], x[1], x[2], x[3]}; *(f32x4*)(po + 4) = (f32x4){x[4], x[5], x[6], x[7]}; }
                    else { *(u32x4*)(XB + grow * DM + col0 + bj * HALF) = pack8(x);
#pragma unroll
                        for (int e = 0; e < 8; ++e) ss2 += x[e] * x[e]; }
                }
                if (!LAST) { ss2 += __shfl_xor(ss2, 16); ss2 += __shfl_xor(ss2, 32); if (fq == 0) XP[rl * 4 + wc] = ss2; }
            }
        if (!LAST) {
            asm volatile("s_waitcnt lgkmcnt(0)" ::: "memory"); __builtin_amdgcn_s_barrier(); asm volatile("" ::: "memory");
            if (t < 256) { const f32x4 p4 = *(const LAS f32x4*)(XP + t * 4); XS[((size_t)u.pm * BM + t) * 4 + u.pn] = (p4[0] + p4[1]) + (p4[2] + p4[3]); }
        }
        asm volatile("s_waitcnt lgkmcnt(0)" ::: "memory"); __builtin_amdgcn_s_barrier(); asm volatile("" ::: "memory");
    }
};
struct EpiSoftmax {
    static constexpr bool PERM = true;
    bf16_t* O; float scale2; const float* rs;
    __device__ __forceinline__ void operator()(f32x4 (&acc)[2][2][4][2], const Unit& u, int wr, int wc, int fr, int fq, LAS unsigned char* xch) const {
        LAS f32x2* X = (LAS f32x2*)xch;
#pragma unroll
        for (int ai = 0; ai < 2; ++ai)
#pragma unroll
            for (int m = 0; m < 4; ++m) {
                float mx = -3.0e38f; const float sc2 = scale2 * rstd4(rs + (size_t)(u.pm * BM + ai * HALF + wr * 64 + m * 16 + fr) * 4);
#pragma unroll
                for (int bj = 0; bj < 2; ++bj)
#pragma unroll
                    for (int n = 0; n < 2; ++n) { f32x4 v = acc[ai][bj][m][n] * sc2; acc[ai][bj][m][n] = v; mx = fmaxf(mx, fmaxf(fmaxf(v[0], v[1]), fmaxf(v[2], v[3]))); }
                mx = fmaxf(mx, __shfl_xor(mx, 16)); mx = fmaxf(mx, __shfl_xor(mx, 32));
                float sm = 0.f;
#pragma unroll
                for (int bj = 0; bj < 2; ++bj)
#pragma unroll
                    for (int n = 0; n < 2; ++n) { f32x4 v = acc[ai][bj][m][n]; v[0] = fexp2(v[0] - mx); v[1] = fexp2(v[1] - mx); v[2] = fexp2(v[2] - mx); v[3] = fexp2(v[3] - mx); acc[ai][bj][m][n] = v; sm += (v[0] + v[1]) + (v[2] + v[3]); }
                sm += __shfl_xor(sm, 16); sm += __shfl_xor(sm, 32);
                if (fq == 0) X[(ai * HALF + wr * 64 + m * 16 + fr) * 4 + wc] = (f32x2){mx, sm};
            }
        asm volatile("s_waitcnt lgkmcnt(0)" ::: "memory"); __builtin_amdgcn_s_barrier(); asm volatile("" ::: "memory");
        const int row0 = u.pm * BM + wr * 64 + fr, col0 = u.pn * BM + wc * 32 + 8 * fq;
#pragma unroll
        for (int ai = 0; ai < 2; ++ai)
#pragma unroll
            for (int m = 0; m < 4; ++m) {
                const int rl = ai * HALF + wr * 64 + m * 16 + fr;
                const f32x2 a = X[rl * 4 + 0], b = X[rl * 4 + 1], c = X[rl * 4 + 2], d = X[rl * 4 + 3];
                const float M = fmaxf(fmaxf(a.x, b.x), fmaxf(c.x, d.x));
                const float tot = a.y * fexp2(a.x - M) + b.y * fexp2(b.x - M) + c.y * fexp2(c.x - M) + d.y * fexp2(d.x - M);
                const f32x2 mine = X[rl * 4 + wc];
                const float f = fexp2(mine.x - M) * frcp(tot);
                bf16_t* rowp = O + (size_t)(row0 + ai * HALF + m * 16) * 1024 + col0;
#pragma unroll
                for (int bj = 0; bj < 2; ++bj) { const f32x4 v0 = acc[ai][bj][m][0] * f, v1 = acc[ai][bj][m][1] * f;
                    u32x4 w; w.x = cvt_pk_bf16(v0[0], v0[1]); w.y = cvt_pk_bf16(v0[2], v0[3]); w.z = cvt_pk_bf16(v1[0], v1[1]); w.w = cvt_pk_bf16(v1[2], v1[3]);
                    *(u32x4*)(rowp + bj * HALF) = w; }
            }
        asm volatile("s_waitcnt lgkmcnt(0)" ::: "memory"); __builtin_amdgcn_s_barrier(); asm volatile("" ::: "memory");
    }
};

template <class Epi, class Sched>
__device__ __forceinline__ void gemm_phase(LAS unsigned char* lds, LAS unsigned char* xch, const Gemm g, const Sched& S, const Epi& E, int wave0) {
    const int ln_ = hw_lane();
    int wid_ = wave0; asm volatile("" : "+s"(wid_));
    const int wid = wid_, lane = ln_, tid = wid * 64 + lane, wr = wid >> 2, wc = wid & 3, fr = lane & 15, fq = lane >> 4;
    int K_ = g.K; asm volatile("" : "+s"(K_));
    const int K = K_, nt = K / BK;
    unsigned voffA[2], voffB[2];
#pragma unroll
    for (int i = 0; i < 2; ++i) { int R, C; stage_rc(tid * 16 + i * 8192, R, C); const int Rb = Epi::PERM ? ((R & ~31) + perm32(R & 31)) : R;
        voffA[i] = (unsigned)(R * g.lda + C) * 2u; voffB[i] = (unsigned)(Rb * g.ldb + C) * 2u; }
    const size_t kstep = (size_t)(BK * 2);
    const size_t hsA = (size_t)HALF * g.lda * 2, hsB = (size_t)HALF * g.ldb * 2;
    const unsigned ldsw = (unsigned)wid * 1024u;
    const int aoff = lds_byte(wr * 64 + fr, fq * 8), boff = lds_byte(wc * 32 + fr, fq * 8);
#define PG8_SA(b, h) (((b) * 2 + (h)) * HTB)
#define PG8_SB(b, h) ((4 + (b) * 2 + (h)) * HTB)
#define PG8_STAGE(bufoff, gbase, voff) do { _Pragma("unroll") for (int _i = 0; _i < 2; ++_i) \
        __builtin_amdgcn_global_load_lds((const unsigned*)((const char*)(gbase) + (voff)[_i]), (LAS unsigned*)(lds + (bufoff) + ldsw + _i * 8192), 16, 0, 0); } while (0)
#define PG8_LDA(dst, b, h) do { _Pragma("unroll") for (int m = 0; m < 4; ++m) _Pragma("unroll") for (int k = 0; k < 2; ++k) dst[m][k] = *(const LAS bf16x8*)(lds + PG8_SA(b, h) + aoff + m * 2048 + k * 1024); } while (0)
#define PG8_LDB(dst, b, h) do { _Pragma("unroll") for (int n = 0; n < 2; ++n) _Pragma("unroll") for (int k = 0; k < 2; ++k) dst[n][k] = *(const LAS bf16x8*)(lds + PG8_SB(b, h) + boff + n * 2048 + k * 1024); } while (0)
#define PG8_MMA(ai, bj, At, Bt) do { __builtin_amdgcn_s_setprio(1); _Pragma("unroll") for (int m = 0; m < 4; ++m) _Pragma("unroll") for (int n = 0; n < 2; ++n) _Pragma("unroll") for (int k = 0; k < 2; ++k) \
        acc[ai][bj][m][n] = __builtin_amdgcn_mfma_f32_16x16x32_bf16(Bt[n][k], At[m][k], acc[ai][bj][m][n], 0, 0, 0); __builtin_amdgcn_s_setprio(0); } while (0)
#define PG8_WAIT_V(n) asm volatile("s_waitcnt vmcnt(" #n ")" ::: "memory")
#define PG8_WAIT_L(n) asm volatile("s_waitcnt lgkmcnt(" #n ")" ::: "memory")
#define PG8_BAR __builtin_amdgcn_s_barrier()
#define PG8_SCHED __builtin_amdgcn_sched_barrier(0)
    Unit cur, nxt; int ui = 0;
    if (!S.next(0, cur)) return;
    f32x4 acc[2][2][4][2];
#pragma unroll
    for (int a = 0; a < 2; ++a)
#pragma unroll
        for (int b = 0; b < 2; ++b)
#pragma unroll
            for (int m = 0; m < 4; ++m)
#pragma unroll
                for (int n = 0; n < 2; ++n) acc[a][b][m][n] = (f32x4){0.f, 0.f, 0.f, 0.f};
    bf16x8 At[4][2], B0[2][2], B1[2][2];
    const char* cA = (const char*)g.A + cur.aoff; const char* cB = (const char*)g.Bt + cur.boff;
    PG8_STAGE(PG8_SB(0, 0), cB, voffB); PG8_STAGE(PG8_SB(0, 1), cB + hsB, voffB); PG8_STAGE(PG8_SA(0, 0), cA, voffA); PG8_STAGE(PG8_SA(0, 1), cA + hsA, voffA);
    if (wr == 1) PG8_BAR;
    PG8_WAIT_V(2); PG8_BAR;
    PG8_STAGE(PG8_SB(1, 0), cB + kstep, voffB); PG8_STAGE(PG8_SA(1, 0), cA + kstep, voffA); PG8_STAGE(PG8_SB(1, 1), cB + hsB + kstep, voffB);
    PG8_WAIT_V(6); PG8_BAR;
    for (;;) {
        const bool has_next = S.next(ui + 1, nxt);
        const char* nA = has_next ? (const char*)g.A + nxt.aoff : cA; const char* nB = has_next ? (const char*)g.Bt + nxt.boff : cB;
#pragma unroll 1
        for (int t = 0; t < nt; t += 2) {
            const bool last = (t == nt - 2);
            const char* a1 = cA + (size_t)(t + 1) * kstep;
            const char* a2 = last ? nA : cA + (size_t)(t + 2) * kstep; const char* b2 = last ? nB : cB + (size_t)(t + 2) * kstep;
            const char* a3 = a2 + kstep; const char* b3 = b2 + kstep;
            PG8_LDB(B0, 0, 0); PG8_LDB(B1, 0, 1); PG8_SCHED; PG8_LDA(At, 0, 0); PG8_STAGE(PG8_SA(1, 1), a1 + hsA, voffA);
            PG8_WAIT_V(8); PG8_WAIT_L(0); PG8_BAR; PG8_MMA(0, 0, At, B0); PG8_MMA(0, 1, At, B1); PG8_BAR; PG8_SCHED;
            PG8_LDA(At, 0, 1); PG8_STAGE(PG8_SB(0, 0), b2, voffB); PG8_STAGE(PG8_SB(0, 1), b2 + hsB, voffB); PG8_STAGE(PG8_SA(0, 0), a2, voffA);
            PG8_WAIT_V(8); PG8_WAIT_L(0); PG8_BAR; PG8_MMA(1, 0, At, B0); PG8_MMA(1, 1, At, B1); PG8_BAR; PG8_SCHED;
            PG8_LDB(B0, 1, 0); PG8_LDB(B1, 1, 1); PG8_SCHED; PG8_LDA(At, 1, 0); PG8_STAGE(PG8_SA(0, 1), a2 + hsA, voffA);
            PG8_WAIT_V(8); PG8_WAIT_L(0); PG8_BAR; PG8_MMA(0, 0, At, B0); PG8_MMA(0, 1, At, B1); PG8_BAR; PG8_SCHED;
            PG8_LDA(At, 1, 1); PG8_STAGE(PG8_SB(1, 0), b3, voffB); PG8_STAGE(PG8_SB(1, 1), b3 + hsB, voffB); PG8_STAGE(PG8_SA(1, 0), a3, voffA);
            PG8_WAIT_V(8); PG8_WAIT_L(0); PG8_BAR; PG8_MMA(1, 0, At, B0); PG8_MMA(1, 1, At, B1); PG8_BAR; PG8_SCHED;
        }
        if (wr == 0) PG8_BAR;
        E(acc, cur, wr, wc, fr, fq, xch);
        if (!has_next) break;
#pragma unroll
        for (int a = 0; a < 2; ++a)
#pragma unroll
            for (int b = 0; b < 2; ++b)
#pragma unroll
                for (int m = 0; m < 4; ++m)
#pragma unroll
                    for (int n = 0; n < 2; ++n) acc[a][b][m][n] = (f32x4){0.f, 0.f, 0.f, 0.f};
        cur = nxt; cA = nA; cB = nB; ++ui;
        if (wr == 1) PG8_BAR;
    }
    PG8_WAIT_V(0);
    PG8_BAR;
#undef PG8_SA
#undef PG8_SB
#undef PG8_STAGE
#undef PG8_LDA
#undef PG8_LDB
#undef PG8_MMA
#undef PG8_WAIT_V
#undef PG8_WAIT_L
#undef PG8_BAR
#undef PG8_SCHED
}
}

struct Args { const float* in[24]; float* out; unsigned char* ws; int ph_lo, ph_hi; };
#define CAS __attribute__((address_space(4)))
struct Frame {
    const CAS unsigned char* kp;
    LAS unsigned char* lds;
    int tid, lane, wave, G, bx, gw, NGW;
    unsigned char* ws;
    __device__ __forceinline__ const float* in(int k) const { return *(const float* const CAS*)(kp + 8 * k); }
};
__device__ __forceinline__ Frame make_frame(LAS unsigned char* lds, int wave0) {
    Frame F;
    const CAS unsigned char* kp = (const CAS unsigned char*)__builtin_amdgcn_kernarg_segment_ptr(); asm volatile("" : "+s"(kp));
    F.kp = kp; F.lds = lds;
    const int ln = hw_lane();
    int wv = wave0; asm volatile("" : "+s"(wv));
    F.lane = ln; F.wave = wv; F.tid = wv * 64 + ln;
    int bx = blockIdx.x, G = gridDim.x; asm volatile("" : "+s"(bx), "+s"(G));
    F.bx = bx; F.G = G; F.gw = bx * NWAVES + F.wave; F.NGW = G * NWAVES;
    F.ws = *(unsigned char* const CAS*)(kp + 200);
    return F;
}

template <bool WINMAP = false>
__device__ __forceinline__ void transpose_item(const float* W, int ldw, int K, int k0, int sc0, int nvalid, bf16_t* Wt, int dr0, LAS float* scr, int lane, const float* kgain = nullptr) {
    if (WINMAP) {
        const int jj = lane & 31; const int scol = win_src_col(dr0 + jj);
#pragma unroll 8
        for (int i = 0; i < 32; ++i) { const int kk = 2 * i + (lane >> 5), j = lane & 31; float w = (scol >= 0) ? W[(size_t)(k0 + kk) * ldw + scol] : 0.f; if (kgain) w *= kgain[k0 + kk]; scr[kk * 33 + j] = w; }
    } else {
        const int n4 = (lane & 7) * 4;
#pragma unroll
        for (int i = 0; i < 8; ++i) { const int kk = (lane >> 3) + 8 * i; f32x4 w = *(const f32x4*)(W + (size_t)(k0 + kk) * ldw + sc0 + n4); if (kgain) w = w * kgain[k0 + kk];
            scr[kk * 33 + n4] = w[0]; scr[kk * 33 + n4 + 1] = w[1]; scr[kk * 33 + n4 + 2] = w[2]; scr[kk * 33 + n4 + 3] = w[3]; }
    }
    LDS_WAIT();
    const int c = lane & 7;
#pragma unroll
    for (int j = 0; j < 4; ++j) { const int n = (lane >> 3) + 8 * j; const LAS float* s = scr + (8 * c) * 33 + n;
        u32x4 o; o.x = cvt_pk_bf16(s[0 * 33], s[1 * 33]); o.y = cvt_pk_bf16(s[2 * 33], s[3 * 33]); o.z = cvt_pk_bf16(s[4 * 33], s[5 * 33]); o.w = cvt_pk_bf16(s[6 * 33], s[7 * 33]);
        *(u32x4*)(Wt + (size_t)(dr0 + n) * K + k0 + 8 * c) = o; }
    LDS_WAIT();
}
__device__ __forceinline__ void convert_rows_item(const float* W, const float* gain, bf16_t* D, int row, int lane) {
    const float g = gain[row];
#pragma unroll
    for (int j = 0; j < 2; ++j) { const float* p = W + (size_t)row * 1024 + 8 * lane + 512 * j; const f32x4 a = *(const f32x4*)p, b = *(const f32x4*)(p + 4);
        const float v[8] = {a[0] * g, a[1] * g, a[2] * g, a[3] * g, b[0] * g, b[1] * g, b[2] * g, b[3] * g}; *(u32x4*)(D + (size_t)row * 1024 + 8 * lane + 512 * j) = pack8(v); }
}
__device__ __forceinline__ void convert_attn_weights(const Frame& F, int l) {
    LAS float* scr = (LAS float*)(F.lds + F.wave * 16384);
    unsigned char* ws = F.ws + ((l & 1) ? WDELTA : 0);
    constexpr int I_IN = 72 * 16, I_UQ = 24 * 4, I_UKV = 32 * 2, I_SQ = 32 * 16, I_R = 1024;
    constexpr int NIT = I_IN + I_UQ + I_UKV + 2 * I_SQ + I_R;
    for (int it = F.gw; it < NIT; it += F.NGW) {
        int r = it;
        if (r < I_IN) { const int nb = r % 72, kb = r / 72, n0 = nb * 32;
            const bool mapped = (n0 >= 384 && n0 < 512) || (n0 >= 1536 && n0 < 2048 && ((n0 - 1536) & 63) == 0);
            if (mapped) transpose_item<true>(F.in(2) + (size_t)l * 1024 * D_IN, D_IN, 1024, kb * 64, 0, 32, (bf16_t*)(ws + WS_WIN), n0, scr, F.lane, F.in(17) + l * DM);
            else transpose_item(F.in(2) + (size_t)l * 1024 * D_IN, D_IN, 1024, kb * 64, win_src_col(n0), 32, (bf16_t*)(ws + WS_WIN), n0, scr, F.lane, F.in(17) + l * DM);
            continue; } r -= I_IN;
        if (r < I_UQ) { const int nb = r % 24, kb = r / 24;
            transpose_item(F.in(4) + (size_t)l * 256 * 768, 768, 256, kb * 64, nb * 32, 32, (bf16_t*)(ws + WS_WUQ), nb * 32, scr, F.lane, F.in(3) + l * 256); continue; } r -= I_UQ;
        if (r < I_UKV) { const int nb = r % 32, kb = r / 32, n0 = nb * 32; const int isv = n0 >= 512, nn = n0 - isv * 512, sc = (nn >> 6) * 128 + isv * 64 + (nn & 63);
            transpose_item(F.in(6) + (size_t)l * 128 * 1024, 1024, 128, kb * 64, sc, 32, (bf16_t*)(ws + WS_WUKV), n0, scr, F.lane, F.in(5) + l * 128); continue; } r -= I_UKV;
        if (r < 2 * I_SQ) { const int which = r / I_SQ, rr = r % I_SQ, nb = rr % 32, kb = rr / 32;
            const float* src = (which == 0 ? F.in(11) : F.in(14)) + (size_t)l * 1024 * 1024;
            bf16_t* dst = which == 0 ? (bf16_t*)(ws + WS_WOUT) : (bf16_t*)(F.ws + WS_WXOT);
            transpose_item(src, 1024, 1024, kb * 64, nb * 32, 32, dst, nb * 32, scr, F.lane); continue; } r -= 2 * I_SQ;
        convert_rows_item(F.in(12) + (size_t)l * 1024 * 1024, F.in(20) + l * DM, (bf16_t*)(F.ws + WS_WXQR), r, F.lane);
    }
}
__device__ __forceinline__ void convert_ffn_weights(const Frame& F, int l) {
    LAS float* scr = (LAS float*)(F.lds + F.wave * 16384);
    unsigned char* ws = F.ws;
    constexpr int I_GU = 176 * 16, I_DN = 32 * 44;
    for (int it = F.gw; it < I_GU + I_DN; it += F.NGW) {
        int r = it;
        if (r < I_GU) { const int nb = r % 176, kb = r / 176, n0 = nb * 32; const int tile = n0 >> 8, bj = (n0 >> 7) & 1, cc = n0 & 127, sc = bj * D_FF + tile * 128 + cc;
            transpose_item(F.in(15) + (size_t)l * 1024 * 2 * D_FF, 2 * D_FF, 1024, kb * 64, sc, 32, (bf16_t*)(ws + WS_WGU), n0, scr, F.lane, F.in(22) + l * DM); continue; } r -= I_GU;
        { const int nb = r % 32, kb = r / 32;
            transpose_item(F.in(16) + (size_t)l * D_FF * 1024, 1024, D_FF, kb * 64, nb * 32, 32, (bf16_t*)(ws + WS_WDN), nb * 32, scr, F.lane); }
    }
}

__device__ __forceinline__ void resid_init_phase(const Frame& F, const float* xin, bf16_t* XB, float* RSTD) {
    for (int row = F.gw; row < T; row += F.NGW) {
        float ss = 0.f;
#pragma unroll
        for (int j = 0; j < 2; ++j) { const float* p = xin + (size_t)row * DM + 8 * F.lane + 512 * j; const f32x4 a = *(const f32x4*)p, b = *(const f32x4*)(p + 4);
            const float v[8] = {a[0], a[1], a[2], a[3], b[0], b[1], b[2], b[3]};
#pragma unroll
            for (int e = 0; e < 8; ++e) ss += v[e] * v[e];
            *(u32x4*)(XB + (size_t)row * DM + 8 * F.lane + 512 * j) = pack8(v); }
        ss = wave_sum(ss);
        if (F.lane == 0) *(f32x4*)(RSTD + (size_t)row * 4) = (f32x4){ss, 0.f, 0.f, 0.f};
    }
}
constexpr int RN_ROWS = 4;
template <bool LAST>
__device__ __forceinline__ void resid_phase(const Frame& F, bf16_t* XB, const bf16_t* Y, const float* gpost, float* RSTD, float* OUT) {
    float g[2][8];
#pragma unroll
    for (int j = 0; j < 2; ++j)
#pragma unroll
        for (int e = 0; e < 8; ++e) g[j][e] = gpost[8 * F.lane + 512 * j + e];
    for (int row0 = F.gw; row0 < T; row0 += RN_ROWS * F.NGW) {
        u32x4 yw[RN_ROWS][2], xw[RN_ROWS][2];
#pragma unroll
        for (int rr = 0; rr < RN_ROWS; ++rr) { const int row = (row0 + rr * F.NGW < T) ? row0 + rr * F.NGW : row0;
#pragma unroll
            for (int j = 0; j < 2; ++j) { yw[rr][j] = *(const u32x4*)(Y + (size_t)row * DM + 8 * F.lane + 512 * j); xw[rr][j] = *(const u32x4*)(XB + (size_t)row * DM + 8 * F.lane + 512 * j); } }
#pragma unroll
        for (int rr = 0; rr < RN_ROWS; ++rr) { const int row = row0 + rr * F.NGW; if (row >= T) break;
            float yv[2][8], xv[2][8]; float ss = 0.f;
#pragma unroll
            for (int j = 0; j < 2; ++j) { unpack8(yw[rr][j], yv[j]); unpack8(xw[rr][j], xv[j]);
#pragma unroll
                for (int e = 0; e < 8; ++e) ss += yv[j][e] * yv[j][e]; }
            const float rstd = 1.0f / sqrtf(wave_sum(ss) * (1.0f / DM) + EPS);
            float s2 = 0.f;
#pragma unroll
            for (int j = 0; j < 2; ++j) {
#pragma unroll
                for (int e = 0; e < 8; ++e) { xv[j][e] += yv[j][e] * rstd * g[j][e]; s2 += xv[j][e] * xv[j][e]; }
                if (LAST) { float* p = OUT + (size_t)row * DM + 8 * F.lane + 512 * j; *(f32x4*)p = (f32x4){xv[j][0], xv[j][1], xv[j][2], xv[j][3]}; *(f32x4*)(p + 4) = (f32x4){xv[j][4], xv[j][5], xv[j][6], xv[j][7]}; }
                else *(u32x4*)(XB + (size_t)row * DM + 8 * F.lane + 512 * j) = pack8(xv[j]); }
            if (!LAST) { s2 = wave_sum(s2); if (F.lane == 0) RSTD[row] = 1.0f / sqrtf(s2 * (1.0f / DM) + EPS); }
        }
    }
}

__device__ __forceinline__ void prologue_misc(const Frame& F) {
    unsigned char* ws = F.ws;
    { const int gt = F.bx * 512 + F.tid, NT_ = F.G * 512;
      float* tmc = (float*)(ws + WS_TMC); float* tms = (float*)(ws + WS_TMS); float* tsc = (float*)(ws + WS_TSC); float* tss = (float*)(ws + WS_TSS);
      for (int e = gt; e < SEQ * 24; e += NT_) {
          const int pos = e / 24, k = e % 24; const bool mla = k < 16; const int i = mla ? k : k - 16; const float drot = mla ? 32.f : 16.f;
          const float inv = (float)pow(500000.0, -(double)(2 * i) / (double)drot);
          const float ang = (float)pos * inv;
          const double ad = (double)ang; const float c = (float)cos(ad), s = (float)sin(ad);
          if (mla) { tmc[pos * 16 + i] = c; tms[pos * 16 + i] = s; } else { tsc[pos * 8 + i] = c; tss[pos * 8 + i] = s; }
      } }
    for (int rr = F.gw; rr < DEPTH * 512; rr += F.NGW) {
        const int l = rr >> 9, row = rr & 511; f32x4 v[4]; float ss = 0.f;
#pragma unroll
        for (int j = 0; j < 4; ++j) { v[j] = *(const f32x4*)(F.in(1) + (size_t)row * DM + 4 * F.lane + 256 * j); ss += (v[j][0] * v[j][0] + v[j][1] * v[j][1]) + (v[j][2] * v[j][2] + v[j][3] * v[j][3]); }
        const float rstd = 1.0f / sqrtf(wave_sum(ss) * (1.0f / DM) + EPS);
#pragma unroll
        for (int j = 0; j < 4; ++j) { const f32x4 g = *(const f32x4*)(F.in(19) + (size_t)l * DM + 4 * F.lane + 256 * j); const f32x4 h = v[j] * rstd * g; u32x2 w; w.x = cvt_pk_bf16(h[0], h[1]); w.y = cvt_pk_bf16(h[2], h[3]);
            *(u32x2*)((bf16_t*)(ws + WS_MEMN) + (size_t)rr * DM + 4 * F.lane + 256 * j) = w; }
    }
    { LAS float* scr = (LAS float*)(F.lds + F.wave * 16384);
      for (int it = F.gw; it < DEPTH * 64 * 16; it += F.NGW) { const int l = it / 1024, rr = it % 1024, nb = rr % 64, kb = rr / 64;
          transpose_item(F.in(13) + (size_t)l * 1024 * 2048, 2048, 1024, kb * 64, nb * 32, 32, (bf16_t*)(ws + WS_WXKVT) + (size_t)l * 2048 * 1024, nb * 32, scr, F.lane); } }
}

__device__ __forceinline__ float wave_scan_sum(float v, int lane) {
#pragma unroll
    for (int o = 1; o < 64; o <<= 1) { const float t = __shfl_up(v, o); if (lane >= o) v += t; }
    return v;
}
__device__ __forceinline__ float wave_scan_max(float v, int lane) {
#pragma unroll
    for (int o = 1; o < 64; o <<= 1) { const float t = __shfl_up(v, o); if (lane >= o) v = fmaxf(v, t); }
    return v;
}
constexpr int ML_STR = 144;
constexpr int ML_GRP_BYTES = 49152;
constexpr int ML_K = 0, ML_V = 18432, ML_C = 36864, ML_F = 46080;

__device__ __forceinline__ void ml1_phase(const Frame& F, const float* convw, const float* convb) {
    unsigned char* ws = F.ws; const int lane = F.lane, grp = F.wave >> 2, gwv = F.wave & 3, gt = F.tid & 255;
    const bf16_t* PROJ = (const bf16_t*)(ws + WS_PROJ); bf16_t* MLQK = (bf16_t*)(ws + WS_MLQK); const float* GATE = (const float*)(ws + WS_GATE);
    float* MLU = (float*)(ws + WS_MLU); float* MLB = (float*)(ws + WS_MLB);
    LAS unsigned char* L = F.lds + grp * ML_GRP_BYTES; LAS float* fs = (LAS float*)(L + ML_F);
    const int r = lane & 31, hi = lane >> 5, blk = (lane >> 4) & 1, q = (lane & 15) >> 2, pp = lane & 3;
    for (int it = 0; ; ++it) {
        const int pair = it * F.G + F.bx; if (pair >= 512) break;
        const int chunk = pair * 2 + grp, bh = chunk >> 7, c = chunk & 127, b = bh >> 2, head = bh & 3; const size_t tok0 = (size_t)b * SEQ + c * 128;
        u32x4 wq[4][4], wk[4][4], wv[4];
#pragma unroll
        for (int i = 0; i < 4; ++i) { const int s = (gt >> 3) + 32 * i, ch = gt & 7;
#pragma unroll
            for (int j = 0; j < 4; ++j) { const int dp = (c * 128 + s + j - 3 >= 0) ? j - 3 : 0; const bf16_t* p = PROJ + (ptrdiff_t)(tok0 + s + dp) * D_INP + head * 64 + ch * 8;
                wq[i][j] = *(const u32x4*)(p + C_MLQ); wk[i][j] = *(const u32x4*)(p + C_MLK); }
            wv[i] = *(const u32x4*)(PROJ + (tok0 + s) * D_INP + C_MLV + head * 64 + ch * 8); }
        if (gwv == 0) {
            const float lf0 = GATE[(tok0 + lane) * 8 + 4 + head], lf1 = GATE[(tok0 + 64 + lane) * 8 + 4 + head];
            const float li0 = GATE[(tok0 + lane) * 8 + head], li1 = GATE[(tok0 + 64 + lane) * 8 + head];
            const float b0 = wave_scan_sum(lf0, lane); const float carry = __shfl(b0, 63); const float b1 = wave_scan_sum(lf1, lane) + carry;
            const float bL = __shfl(b1, 63);
            const float g0 = bL - b0 + li0, g1 = bL - b1 + li1;
            float mx = fmaxf(g0, g1);
#pragma unroll
            for (int o = 1; o < 64; o <<= 1) mx = fmaxf(mx, __shfl_xor(mx, o));
            fs[lane] = expf(g0 - mx); fs[64 + lane] = expf(g1 - mx);
            if (lane == 0) { MLB[chunk * 2] = bL; MLB[chunk * 2 + 1] = mx; }
        }
        __syncthreads();
#pragma unroll
        for (int qk = 0; qk < 2; ++qk) {
            const int ch = gt & 7, cch = qk * 256 + head * 64 + ch * 8;
            float cw[4][8], cb[8];
#pragma unroll
            for (int j = 0; j < 4; ++j)
#pragma unroll
                for (int e = 0; e < 8; ++e) cw[j][e] = convw[j * 512 + cch + e];
#pragma unroll
            for (int e = 0; e < 8; ++e) cb[e] = convb[cch + e];
            const float ksc = qk ? 0.125f : 1.0f;
#pragma unroll
            for (int i = 0; i < 4; ++i) { const int s = (gt >> 3) + 32 * i;
                float a[8];
#pragma unroll
                for (int e = 0; e < 8; ++e) a[e] = cb[e];
#pragma unroll
                for (int j = 0; j < 4; ++j) { const int dp = j - 3;
                    if (c * 128 + s + dp >= 0) { const u32x4 w = qk ? wk[i][j] : wq[i][j];
                        a[0] += cw[j][0] * bflo(w.x); a[1] += cw[j][1] * bfhi(w.x); a[2] += cw[j][2] * bflo(w.y); a[3] += cw[j][3] * bfhi(w.y);
                        a[4] += cw[j][4] * bflo(w.z); a[5] += cw[j][5] * bfhi(w.z); a[6] += cw[j][6] * bflo(w.w); a[7] += cw[j][7] * bfhi(w.w); } }
#pragma unroll
                for (int e = 0; e < 8; ++e) a[e] = a[e] * frcp(1.f + fexp2(-a[e] * LOG2E)) * ksc;
                const u32x4 kb = pack8(a);
                *(u32x4*)(MLQK + (tok0 + s) * 512 + qk * 256 + head * 64 + ch * 8) = kb;
                if (qk) { const float w = fs[s];
                    u32x4 o; o.x = cvt_pk_bf16(bflo(kb.x) * w, bfhi(kb.x) * w); o.y = cvt_pk_bf16(bflo(kb.y) * w, bfhi(kb.y) * w); o.z = cvt_pk_bf16(bflo(kb.z) * w, bfhi(kb.z) * w); o.w = cvt_pk_bf16(bflo(kb.w) * w, bfhi(kb.w) * w);
                    *(LAS u32x4*)(L + ML_K + s * ML_STR + ch * 16) = o;
                    *(LAS u32x4*)(L + ML_V + s * ML_STR + ch * 16) = wv[i]; }
            }
        }
        __syncthreads();
        { const int vi = gwv >> 1, kj = gwv & 1; f32x16 acc = {};
#pragma unroll
          for (int ks = 0; ks < 8; ++ks) {
              const int row = 16 * ks + 8 * hi + q;
              const LAS unsigned char* pa = L + ML_V + row * ML_STR + (32 * vi + 16 * blk + 4 * pp) * 2;
              const LAS unsigned char* pb = L + ML_K + row * ML_STR + (32 * kj + 16 * blk + 4 * pp) * 2;
              const bf16x8 A = cat4(tr_read(pa), tr_read(pa + 4 * ML_STR)), B = cat4(tr_read(pb), tr_read(pb + 4 * ML_STR));
              acc = __builtin_amdgcn_mfma_f32_32x32x16_bf16(A, B, acc, 0, 0, 0);
          }
          float* U = MLU + (size_t)chunk * 4160;
#pragma unroll
          for (int reg = 0; reg < 16; ++reg) U[(32 * vi + crow(reg, hi)) * 64 + 32 * kj + r] = acc[reg];
        }
        if (gt < 64) { float s = 0.f;
            for (int t = 0; t < 128; ++t) s += bf2f(*(const LAS bf16_t*)(L + ML_K + t * ML_STR + gt * 2));
            MLU[(size_t)chunk * 4160 + 4096 + gt] = s; }
        __syncthreads();
    }
}
constexpr int ML2_WGS = (8 * 4160 + 511) / 512;
__device__ __forceinline__ void ml2_phase(const Frame& F) {
    unsigned char* ws = F.ws;
    const float* MLU = (const float*)(ws + WS_MLU); const float* MLB = (const float*)(ws + WS_MLB);
    bf16_t* MLC = (bf16_t*)(ws + WS_MLC); float* MLN = (float*)(ws + WS_MLN); float* MLM = (float*)(ws + WS_MLM);
    const int gt = F.bx * 512 + F.tid;
    if (gt >= 8 * 4160) return;
    const int bh = gt / 4160, e = gt % 4160;
    float st = 0.f, m = -1e30f;
    for (int c0 = 0; c0 < 128; c0 += 32) {
        float u[32], bl[32], ml[32];
#pragma unroll
        for (int j = 0; j < 32; ++j) { const int chunk = bh * 128 + c0 + j; u[j] = MLU[(size_t)chunk * 4160 + e]; bl[j] = MLB[chunk * 2]; ml[j] = MLB[chunk * 2 + 1]; }
#pragma unroll
        for (int j = 0; j < 32; ++j) { const int chunk = bh * 128 + c0 + j;
            if (e < 4096) MLC[(size_t)chunk * 4096 + e] = f2bf(st); else MLN[chunk * 64 + e - 4096] = st;
            if (e == 0) MLM[chunk] = m;
            const float mn = fmaxf(bl[j] + m, ml[j]);
            st = fexp2((bl[j] + m - mn) * LOG2E) * st + fexp2((ml[j] - mn) * LOG2E) * u[j]; m = mn; }
    }
}
__device__ __forceinline__ void ml3_phase(const Frame& F) {
    unsigned char* ws = F.ws; const int lane = F.lane, grp = F.wave >> 2, gwv = F.wave & 3, gt = F.tid & 255;
    const bf16_t* PROJ = (const bf16_t*)(ws + WS_PROJ); const bf16_t* MLQK = (const bf16_t*)(ws + WS_MLQK); const float* GATE = (const float*)(ws + WS_GATE);
    const bf16_t* MLC = (const bf16_t*)(ws + WS_MLC); const float* MLN = (const float*)(ws + WS_MLN); const float* MLM = (const float*)(ws + WS_MLM);
    bf16_t* MIX = (bf16_t*)*(float* const CAS*)(F.kp + 192);
    LAS unsigned char* L = F.lds + grp * ML_GRP_BYTES; LAS float* fa = (LAS float*)(L + ML_F); LAS float* frt = fa + 128; LAS float* fwi = fa + 256; LAS float* fem = fa + 384; LAS float* fn = fa + 512;
    const int r = lane & 31, hi = lane >> 5, blk = (lane >> 4) & 1, q = (lane & 15) >> 2, pp = lane & 3;
    for (int it = 0; ; ++it) {
        const int pair = it * F.G + F.bx; if (pair >= 512) break;
        const int chunk = pair * 2 + grp, bh = chunk >> 7, c = chunk & 127, b = bh >> 2, head = bh & 3; const size_t tok0 = (size_t)b * SEQ + c * 128;
        if (gwv == 0) {
            const float lf0 = GATE[(tok0 + lane) * 8 + 4 + head], lf1 = GATE[(tok0 + 64 + lane) * 8 + 4 + head];
            const float li0 = GATE[(tok0 + lane) * 8 + head], li1 = GATE[(tok0 + 64 + lane) * 8 + head];
            const float b0 = wave_scan_sum(lf0, lane); const float carry = __shfl(b0, 63); const float b1 = wave_scan_sum(lf1, lane) + carry;
            const float a0 = li0 - b0, a1 = li1 - b1;
            const float p0 = wave_scan_max(a0, lane); const float pc = __shfl(p0, 63); const float p1 = fmaxf(wave_scan_max(a1, lane), pc);
            const float m = MLM[chunk];
            const float mt0 = fmaxf(b0 + m, b0 + p0), mt1 = fmaxf(b1 + m, b1 + p1);
            fa[lane] = a0; fa[64 + lane] = a1; frt[lane] = b0 - mt0; frt[64 + lane] = b1 - mt1;
            fwi[lane] = expf(b0 + m - mt0); fwi[64 + lane] = expf(b1 + m - mt1); fem[lane] = expf(-mt0); fem[64 + lane] = expf(-mt1);
        }
#pragma unroll
        for (int i = 0; i < 4; ++i) { const int id = gt + 256 * i, s = id >> 3, ch = id & 7;
            *(LAS u32x4*)(L + ML_K + s * ML_STR + ch * 16) = *(const u32x4*)(MLQK + (tok0 + s) * 512 + 256 + head * 64 + ch * 8);
            *(LAS u32x4*)(L + ML_V + s * ML_STR + ch * 16) = *(const u32x4*)(PROJ + (tok0 + s) * D_INP + C_MLV + head * 64 + ch * 8); }
#pragma unroll
        for (int i = 0; i < 2; ++i) { const int id = gt + 256 * i, v = id >> 3, ch = id & 7;
            *(LAS u32x4*)(L + ML_C + v * ML_STR + ch * 16) = *(const u32x4*)(MLC + (size_t)chunk * 4096 + v * 64 + ch * 8); }
        if (gt < 64) fn[gt] = MLN[chunk * 64 + gt];
        __syncthreads();
        {
            const int tq = 32 * gwv + r; const size_t tokq = tok0 + tq;
            bf16x8 qf[4]; float qn = 0.f;
#pragma unroll
            for (int s = 0; s < 4; ++s) { qf[s] = *(const bf16x8*)(MLQK + tokq * 512 + head * 64 + 16 * s + 8 * hi);
#pragma unroll
                for (int j = 0; j < 8; ++j) qn += bf2f((unsigned short)qf[s][j]) * fn[16 * s + 8 * hi + j]; }
            qn += __shfl_xor(qn, 32);
            f32x16 acc[2] = {{}, {}};
#pragma unroll
            for (int dvb = 0; dvb < 2; ++dvb)
#pragma unroll
                for (int s = 0; s < 4; ++s) { const bf16x8 A = *(const LAS bf16x8*)(L + ML_C + (32 * dvb + r) * ML_STR + (16 * s + 8 * hi) * 2);
                    acc[dvb] = __builtin_amdgcn_mfma_f32_32x32x16_bf16(A, qf[s], acc[dvb], 0, 0, 0); }
            const float wi = fwi[tq], rt = frt[tq];
            acc[0] = acc[0] * wi; acc[1] = acc[1] * wi;
            float sintra = 0.f;
            for (int kb = 0; kb <= gwv; ++kb) {
                f32x16 st = {};
#pragma unroll
                for (int s = 0; s < 4; ++s) { const bf16x8 A = *(const LAS bf16x8*)(L + ML_K + (32 * kb + r) * ML_STR + (16 * s + 8 * hi) * 2);
                    st = __builtin_amdgcn_mfma_f32_32x32x16_bf16(A, qf[s], st, 0, 0, 0); }
#pragma unroll
                for (int reg = 0; reg < 16; ++reg) { const int c = 32 * kb + (reg & 3) + 8 * (reg >> 2);
                    const float w = (c <= tq - 4 * hi) ? fexp2((rt + fa[c + 4 * hi]) * LOG2E) : 0.f; const float pv = st[reg] * w; st[reg] = pv; sintra += pv; }
#pragma unroll
                for (int sp = 0; sp < 2; ++sp) {
                    u32x4 pw; pw.x = cvt_pk_bf16(st[8 * sp + 0], st[8 * sp + 1]); pw.y = cvt_pk_bf16(st[8 * sp + 2], st[8 * sp + 3]); pw.z = cvt_pk_bf16(st[8 * sp + 4], st[8 * sp + 5]); pw.w = cvt_pk_bf16(st[8 * sp + 6], st[8 * sp + 7]);
                    const bf16x8 P = __builtin_bit_cast(bf16x8, pw);
#pragma unroll
                    for (int dvb = 0; dvb < 2; ++dvb) { const LAS unsigned char* pa = L + ML_V + (32 * kb + 16 * sp + 4 * hi + q) * ML_STR + (32 * dvb + 16 * blk + 4 * pp) * 2;
                        const bf16x8 A = cat4(tr_read(pa), tr_read(pa + 8 * ML_STR));
                        acc[dvb] = __builtin_amdgcn_mfma_f32_32x32x16_bf16(A, P, acc[dvb], 0, 0, 0); }
                }
            }
            sintra += __shfl_xor(sintra, 32);
            const float nq = wi * qn + sintra; const float inv = 1.0f / fmaxf(fabsf(nq), fem[tq]);
#pragma unroll
            for (int dvb = 0; dvb < 2; ++dvb)
#pragma unroll
                for (int g = 0; g < 4; ++g) { const int v = 32 * dvb + 8 * g + 4 * hi;
                    const u32x2 ow = *(const u32x2*)(PROJ + tokq * D_INP + C_MLO + head * 64 + v);
                    const float o0 = bflo(ow.x), o1 = bfhi(ow.x), o2 = bflo(ow.y), o3 = bfhi(ow.y);
                    const float h0 = acc[dvb][4 * g + 0] * inv * frcp(1.f + fexp2(-o0 * LOG2E)), h1 = acc[dvb][4 * g + 1] * inv * frcp(1.f + fexp2(-o1 * LOG2E));
                    const float h2 = acc[dvb][4 * g + 2] * inv * frcp(1.f + fexp2(-o2 * LOG2E)), h3 = acc[dvb][4 * g + 3] * inv * frcp(1.f + fexp2(-o3 * LOG2E));
                    u32x2 w; w.x = cvt_pk_bf16(h0, h1); w.y = cvt_pk_bf16(h2, h3);
                    *(u32x2*)(MIX + tokq * 1024 + 512 + head * 64 + v) = w; }
        }
        __syncthreads();
    }
}

template <int NKB, int VSTR>
__device__ __forceinline__ void softmax_pv(f32x16 (&st)[NKB], const unsigned (&vm)[NKB], bool masked, float& m, float& l, f32x16 (&o)[2], const LAS unsigned char* vt, int hi, int blk, int q, int pp) {
    float mx = -1e30f;
#pragma unroll
    for (int kb = 0; kb < NKB; ++kb)
#pragma unroll
        for (int reg = 0; reg < 16; ++reg) mx = fmaxf(mx, st[kb][reg]);
    mx = fmaxf(mx, __shfl_xor(mx, 32));
    const float mn = fmaxf(m, mx), alpha = fexp2(m - mn);
    m = mn; l *= alpha; o[0] = o[0] * alpha; o[1] = o[1] * alpha;
    float ls = 0.f;
#pragma unroll
    for (int kb = 0; kb < NKB; ++kb)
#pragma unroll
        for (int reg = 0; reg < 16; ++reg) { float p = fexp2(st[kb][reg] - mn); if (masked && !((vm[kb] >> reg) & 1u)) p = 0.f; st[kb][reg] = p; ls += p; }
    l += ls;
#pragma unroll
    for (int kb = 0; kb < NKB; ++kb)
#pragma unroll
        for (int sp = 0; sp < 2; ++sp) {
            u32x4 pw; pw.x = cvt_pk_bf16(st[kb][8 * sp + 0], st[kb][8 * sp + 1]); pw.y = cvt_pk_bf16(st[kb][8 * sp + 2], st[kb][8 * sp + 3]); pw.z = cvt_pk_bf16(st[kb][8 * sp + 4], st[kb][8 * sp + 5]); pw.w = cvt_pk_bf16(st[kb][8 * sp + 6], st[kb][8 * sp + 7]);
            const bf16x8 P = __builtin_bit_cast(bf16x8, pw);
#pragma unroll
            for (int dvb = 0; dvb < 2; ++dvb) { const LAS unsigned char* pa = vt + (32 * kb + 16 * sp + 4 * hi + q) * VSTR + (32 * dvb + 16 * blk + 4 * pp) * 2;
                const bf16x8 A = cat4(tr_read(pa), tr_read(pa + 8 * VSTR));
                o[dvb] = __builtin_amdgcn_mfma_f32_32x32x16_bf16(A, P, o[dvb], 0, 0, 0); }
        }
}

constexpr int MLA_KSTR = 208, MLA_VSTR = 192, MLA_KB = 64 * MLA_KSTR, MLA_VB = 64 * MLA_VSTR, MLA_VOFF = 2 * MLA_KB;
constexpr float MLA_THR = 8.0f, MLA_HEAD = 7.f;
struct MlaState { float m, l; };
typedef __bf16 bf16x2_t __attribute__((ext_vector_type(2)));
__device__ __forceinline__ float dot2ones(unsigned w, float acc) { return __builtin_amdgcn_fdot2_f32_bf16(__builtin_bit_cast(bf16x2_t, w), __builtin_bit_cast(bf16x2_t, 0x3f803f80u), acc, false); }
__device__ __forceinline__ float max3f(float a, float b, float c) { return __builtin_fmaxf(__builtin_fmaxf(a, b), c); }
__device__ __forceinline__ float swapmax32(float v) {
    auto rr = __builtin_amdgcn_permlane32_swap(__float_as_uint(v), __float_as_uint(v), false, false);
    return fmaxf(__uint_as_float(rr[0]), __uint_as_float(rr[1]));
}
__device__ __forceinline__ void mla_mask(int t, int qw0, int qi, int hi, f32x16 (&C)[2]) {
    if (64 * t + 63 > qw0) {
        int d2 = qi - 64 * t - 4 * hi; asm volatile("" : "+v"(d2));
#pragma unroll
        for (int kb = 0; kb < 2; ++kb)
#pragma unroll
            for (int reg = 0; reg < 16; ++reg) C[kb][reg] = (32 * kb + (reg & 3) + 8 * (reg >> 2) > d2) ? -1e30f : C[kb][reg];
    }
}
__device__ __forceinline__ float mla_rowmax(const f32x16 (&C)[2]) {
    float mxa = max3f(C[0][0], C[0][1], C[1][0]), mxb = max3f(C[0][2], C[0][3], C[1][1]); mxa = max3f(mxa, C[1][2], C[1][3]);
#pragma unroll
    for (int reg = 4; reg < 16; reg += 4) { mxa = max3f(mxa, C[0][reg], C[0][reg + 1]); mxb = max3f(mxb, C[0][reg + 2], C[0][reg + 3]); mxa = max3f(mxa, C[1][reg], C[1][reg + 1]); mxb = max3f(mxb, C[1][reg + 2], C[1][reg + 3]); }
    return swapmax32(fmaxf(mxa, mxb));
}
__device__ __forceinline__ void mla_pack(const f32x16 (&P)[2], u32x4 (&pf)[2][2]) {
#pragma unroll
    for (int kb = 0; kb < 2; ++kb)
#pragma unroll
        for (int sp = 0; sp < 2; ++sp) { pf[kb][sp].x = cvt_pk_bf16(P[kb][8 * sp + 0], P[kb][8 * sp + 1]); pf[kb][sp].y = cvt_pk_bf16(P[kb][8 * sp + 2], P[kb][8 * sp + 3]);
            pf[kb][sp].z = cvt_pk_bf16(P[kb][8 * sp + 4], P[kb][8 * sp + 5]); pf[kb][sp].w = cvt_pk_bf16(P[kb][8 * sp + 6], P[kb][8 * sp + 7]); }
}
__device__ __forceinline__ float mla_rowsum(const u32x4 (&pf)[2][2]) {
    float s0 = 0.f, s1 = 0.f;
#pragma unroll
    for (int kb = 0; kb < 2; ++kb)
#pragma unroll
        for (int sp = 0; sp < 2; ++sp) { s0 = dot2ones(pf[kb][sp].x, s0); s1 = dot2ones(pf[kb][sp].y, s1); s0 = dot2ones(pf[kb][sp].z, s0); s1 = dot2ones(pf[kb][sp].w, s1); }
    return s0 + s1;
}
__device__ __forceinline__ void mla_qk(const LAS unsigned char* kbuf, const bf16x8 (&qf)[6], const f32x16& negm, f32x16 (&C)[2], int r, int hi) {
#pragma unroll
    for (int s = 0; s < 6; ++s)
#pragma unroll
        for (int kb = 0; kb < 2; ++kb) { const bf16x8 A = *(const LAS bf16x8*)(kbuf + (32 * kb + r) * MLA_KSTR + (16 * s + 8 * hi) * 2);
            C[kb] = __builtin_amdgcn_mfma_f32_32x32x16_bf16(A, qf[s], s == 0 ? negm : C[kb], 0, 0, 0); }
}
__device__ __forceinline__ void mla_pv(const LAS unsigned char* vbuf, const u32x4 (&pf)[2][2], f32x16 (&o)[2], int hi, int blk, int q, int pp) {
    const LAS unsigned char* pv0 = vbuf + (4 * hi + q) * MLA_VSTR + (16 * blk + 4 * pp) * 2;
#pragma unroll
    for (int k = 0; k < 4; ++k) {
        const LAS unsigned char* pk = pv0 + (16 * k) * MLA_VSTR;
        const bf16x8 v0 = cat4(tr_read(pk), tr_read(pk + 8 * MLA_VSTR)), v1 = cat4(tr_read(pk + 64), tr_read(pk + 64 + 8 * MLA_VSTR));
        const bf16x8 P = __builtin_bit_cast(bf16x8, pf[k >> 1][k & 1]);
        o[0] = __builtin_amdgcn_mfma_f32_32x32x16_bf16(v0, P, o[0], 0, 0, 0);
        o[1] = __builtin_amdgcn_mfma_f32_32x32x16_bf16(v1, P, o[1], 0, 0, 0);
    }
}
template <bool DOQK, bool DOPV>
__device__ __forceinline__ bf16x8 mla_frag(int i, const LAS unsigned char* pk0, const LAS unsigned char* pv0) {
    if (i < 8) { if (!DOPV) return bf16x8{}; const LAS unsigned char* p = pv0 + (16 * (i >> 1)) * MLA_VSTR + 64 * (i & 1); return cat4(tr_read(p), tr_read(p + 8 * MLA_VSTR)); }
    if (!DOQK) return bf16x8{};
    const int j = i - 8; return *(const LAS bf16x8*)(pk0 + 32 * (j & 1) * MLA_KSTR + 32 * (j >> 1));
}
struct MlaStage { u32x4 rk[2], rv[2]; u32x2 rr[2]; };
template <bool DOQK, bool DOPV, bool DOSM, bool DOSTG, bool DOPRE, bool HAVEPRE, int TP>
__device__ __forceinline__ void mla_step(int tp, int qw0, int qi, const LAS unsigned char* lk0, const LAS unsigned char* lv0, const bf16x8 (&qf)[6], f32x16& negm, f32x16 (&o)[2], MlaState& S,
                                         f32x16 (&C)[2], f32x16 (&Pp)[2], const u32x4 (&pfin)[2][2], u32x4 (&pfout)[2][2], bf16x8 (&vpre)[3], MlaStage& G,
                                         LAS unsigned char* lkw, LAS unsigned char* lkr, LAS unsigned char* lvw, const char* gk0, const char* gk1, const char* gr0, const char* gr1, const char* gv0, const char* gv1,
                                         unsigned gvo, unsigned gro, int hi) {
    if (DOSM) mla_mask(tp, qw0, qi, hi, Pp);
    const LAS unsigned char* const pk0 = lk0 + TP * MLA_KB;
    const LAS unsigned char* const pv0 = lv0 + ((TP + 2) & 3) * MLA_VB;
    const LAS unsigned char* const pn0 = lv0 + ((TP + 3) & 3) * MLA_VB;
    if (DOSTG) {
        *(LAS u32x4*)(lkw + ((TP + 2) & 3) * MLA_KB) = G.rk[0]; *(LAS u32x2*)(lkr + ((TP + 2) & 3) * MLA_KB) = G.rr[0]; *(LAS u32x4*)(lkw + ((TP + 3) & 3) * MLA_KB) = G.rk[1]; *(LAS u32x2*)(lkr + ((TP + 3) & 3) * MLA_KB) = G.rr[1];
        *(LAS u32x4*)(lvw + TP * MLA_VB) = G.rv[0]; *(LAS u32x4*)(lvw + ((TP + 1) & 3) * MLA_VB) = G.rv[1];
        unsigned vk = gvo, vr = gro; asm volatile("" : "+v"(vk), "+v"(vr));
        G.rk[0] = *(const u32x4*)(gk0 + vk); G.rr[0] = *(const u32x2*)(gr0 + vr); G.rk[1] = *(const u32x4*)(gk1 + vk); G.rr[1] = *(const u32x2*)(gr1 + vr);
        G.rv[0] = *(const u32x4*)(gv0 + vk); G.rv[1] = *(const u32x4*)(gv1 + vk);
    }
    constexpr int MO[23] = {0, 1, 2, 8, 3, 9, 4, 10, 5, 11, 6, 12, 7, 13, 14, 15, 16, 17, 18, 19, 20, 20, 20};
    bf16x8 fr[23];
    float s0 = 0.f, s1 = 0.f;
    unsigned pw[16];
    if (DOPV && HAVEPRE) { fr[0] = vpre[0]; fr[1] = vpre[1]; fr[2] = vpre[2]; }
    else { fr[0] = mla_frag<DOQK, DOPV>(MO[0], pk0, pv0); fr[1] = mla_frag<DOQK, DOPV>(MO[1], pk0, pv0); fr[2] = mla_frag<DOQK, DOPV>(MO[2], pk0, pv0); }
    __builtin_amdgcn_sched_barrier(0);
#pragma unroll
    for (int i = 0; i < 20; ++i) {
        if (i + 3 < 20) fr[i + 3] = mla_frag<DOQK, DOPV>(MO[i + 3], pk0, pv0);
        if (DOPRE && i >= 17) vpre[i - 17] = mla_frag<false, true>(i - 17, pn0, pn0);
        { const int mi = MO[i];
          if (mi < 8) { if (DOPV) o[mi & 1] = __builtin_amdgcn_mfma_f32_32x32x16_bf16(fr[i], __builtin_bit_cast(bf16x8, pfin[mi >> 2][(mi >> 1) & 1]), o[mi & 1], 0, 0, 0); }
          else if (DOQK) { const int j = mi - 8, s = j >> 1, kb = j & 1; C[kb] = __builtin_amdgcn_mfma_f32_32x32x16_bf16(fr[i], qf[s], s == 0 ? negm : C[kb], 0, 0, 0); } }
        if (DOSM) {
            if (i < 16) { const int kb = i >> 3, reg = 2 * (i & 7); Pp[kb][reg] = fexp2(Pp[kb][reg]); Pp[kb][reg + 1] = fexp2(Pp[kb][reg + 1]); }
            if (i >= 2 && i < 18) { const int e = i - 2, kb = e >> 3, reg = 2 * (e & 7); pw[e] = cvt_pk_bf16(Pp[kb][reg], Pp[kb][reg + 1]); }
            if (i >= 3 && i < 19) { const int e = i - 3; if (e & 1) s1 = dot2ones(pw[e], s1); else s0 = dot2ones(pw[e], s0); }
        }
        __builtin_amdgcn_sched_barrier(0);
    }
    if (DOSM) {
#pragma unroll
        for (int kb = 0; kb < 2; ++kb)
#pragma unroll
            for (int sp = 0; sp < 2; ++sp) { pfout[kb][sp].x = pw[8 * kb + 4 * sp]; pfout[kb][sp].y = pw[8 * kb + 4 * sp + 1]; pfout[kb][sp].z = pw[8 * kb + 4 * sp + 2]; pfout[kb][sp].w = pw[8 * kb + 4 * sp + 3]; }
        const float ts = s0 + s1; S.l += ts;
        if (__any(ts >= 2.0f)) {
            const float dl = fmaxf(flog2(mla_rowmax(Pp)) + MLA_HEAD, 0.f), f = fexp2(-dl);
            S.m += dl; S.l *= f;
#pragma unroll
            for (int reg = 0; reg < 16; ++reg) negm[reg] = -S.m;
            asm volatile("" : "+v"(negm));
            Pp[0] = Pp[0] * f; Pp[1] = Pp[1] * f; mla_pack(Pp, pfout);
            o[0] = o[0] * f; o[1] = o[1] * f;
            if (DOQK) {
#pragma unroll
                for (int kb = 0; kb < 2; ++kb)
#pragma unroll
                    for (int reg = 0; reg < 16; ++reg) C[kb][reg] -= dl; }
        }
    }
}
constexpr int MLA_VOFF4 = 4 * MLA_KB;
__device__ __forceinline__ void mla_unit(const Frame& F, int b, int h, int qb) {
    int tid_ = F.tid; asm volatile("" : "+v"(tid_));
    unsigned char* ws = F.ws; const int tid = tid_, lane = tid & 63, wid = F.wave;
    const bf16_t* Q = (const bf16_t*)(ws + WS_Q); const bf16_t* KV = (const bf16_t*)(ws + WS_KV); const bf16_t* KPE = (const bf16_t*)(ws + WS_KPE); bf16_t* MIX = (bf16_t*)*(float* const CAS*)(F.kp + 192);
    const int r = lane & 31, hi = lane >> 5, blk = (lane >> 4) & 1, q = (lane & 15) >> 2, pp = lane & 3;
    const size_t rowb = (size_t)b * SEQ; const int qw0 = qb * 256 + wid * 32, qi = qw0 + r;
    bf16x8 qf[6];
#pragma unroll
    for (int s = 0; s < 6; ++s) qf[s] = *(const bf16x8*)(Q + (rowb + qi) * 768 + h * 96 + 16 * s + 8 * hi);
    const int srow = tid >> 3, sch = tid & 7;
    const unsigned voK = (unsigned)(srow * 1024 + sch * 8) * 2u, voR = (unsigned)(srow * 32 + sch * 4) * 2u;
    const char* const bK = (const char*)(KV + rowb * 1024 + h * 64); const char* const bV = bK + 512 * 2; const char* const bR = (const char*)(KPE + rowb * 32);
    const int NT = 4 * (qb + 1);
    LAS unsigned char* const L = F.lds;
    const int kwo = srow * MLA_KSTR + sch * 16, kro = srow * MLA_KSTR + 128 + sch * 8, vwo = MLA_VOFF4 + srow * MLA_VSTR + sch * 16;
#define MLA_LDK(tile) (*(const u32x4*)(bK + (size_t)(tile) * (64 * 1024 * 2) + voK))
#define MLA_LDV(tile) (*(const u32x4*)(bV + (size_t)(tile) * (64 * 1024 * 2) + voK))
#define MLA_LDR(tile) (*(const u32x2*)(bR + (size_t)(tile) * (64 * 32 * 2) + voR))
#define MLA_BAR() do { asm volatile("s_waitcnt lgkmcnt(0)" ::: "memory"); __builtin_amdgcn_s_barrier(); asm volatile("" ::: "memory"); } while (0)
    MlaStage G;
    { const u32x4 k0 = MLA_LDK(0), k1 = MLA_LDK(1); const u32x2 r0 = MLA_LDR(0), r1 = MLA_LDR(1);
      G.rk[0] = MLA_LDK(2); G.rr[0] = MLA_LDR(2); G.rk[1] = MLA_LDK(3); G.rr[1] = MLA_LDR(3); G.rv[0] = MLA_LDV(0); G.rv[1] = MLA_LDV(1);
      *(LAS u32x4*)(L + kwo) = k0; *(LAS u32x2*)(L + kro) = r0; *(LAS u32x4*)(L + MLA_KB + kwo) = k1; *(LAS u32x2*)(L + MLA_KB + kro) = r1; }
    MLA_BAR();
    int ko = r * MLA_KSTR + 16 * hi, vo = (4 * hi + q) * MLA_VSTR + (16 * blk + 4 * pp) * 2; asm volatile("" : "+v"(ko), "+v"(vo));
    MlaState S; S.m = 0.f; S.l = 0.f;
    f32x16 negm = {}, o[2] = {{}, {}}, CA[2], CB[2];
    u32x4 pfE[2][2], pfO[2][2];
    bf16x8 vpre[3];
    const LAS unsigned char* lk0; const LAS unsigned char* lv0; LAS unsigned char* lkw; LAS unsigned char* lkr; LAS unsigned char* lvw;
    { unsigned a0 = (unsigned)(size_t)L + (unsigned)ko, a1 = (unsigned)(size_t)L + (unsigned)kwo, a2 = (unsigned)(size_t)L + (unsigned)kro, a3 = (unsigned)(size_t)L + (unsigned)(MLA_VOFF4 + vo), a4 = (unsigned)(size_t)L + (unsigned)vwo;
      asm volatile("" : "+v"(a0), "+v"(a1), "+v"(a2), "+v"(a3), "+v"(a4));
      lk0 = (const LAS unsigned char*)(size_t)a0; lkw = (LAS unsigned char*)(size_t)a1; lkr = (LAS unsigned char*)(size_t)a2; lv0 = (const LAS unsigned char*)(size_t)a3; lvw = (LAS unsigned char*)(size_t)a4; }
    { *(LAS u32x4*)(L + 2 * MLA_KB + kwo) = G.rk[0]; *(LAS u32x2*)(L + 2 * MLA_KB + kro) = G.rr[0]; *(LAS u32x4*)(L + 3 * MLA_KB + kwo) = G.rk[1]; *(LAS u32x2*)(L + 3 * MLA_KB + kro) = G.rr[1];
      *(LAS u32x4*)(L + vwo) = G.rv[0]; *(LAS u32x4*)(L + MLA_VB + vwo) = G.rv[1];
      const int t4 = 4 < NT ? 4 : NT - 1, t5 = 5 < NT ? 5 : NT - 1;
      G.rk[0] = MLA_LDK(t4); G.rr[0] = MLA_LDR(t4); G.rk[1] = MLA_LDK(t5); G.rr[1] = MLA_LDR(t5); G.rv[0] = MLA_LDV(2); G.rv[1] = MLA_LDV(3); }
    mla_qk(L, qf, negm, CA, r, hi);
    mla_qk(L + MLA_KB, qf, negm, CB, r, hi);
    { mla_mask(0, qw0, qi, hi, CA); const float mx = mla_rowmax(CA) + MLA_HEAD; S.m = mx;
#pragma unroll
      for (int kb = 0; kb < 2; ++kb)
#pragma unroll
          for (int reg = 0; reg < 16; ++reg) { CA[kb][reg] = fexp2(CA[kb][reg] - mx); CB[kb][reg] -= mx; }
#pragma unroll
      for (int reg = 0; reg < 16; ++reg) negm[reg] = -mx;
      asm volatile("" : "+v"(negm));
      asm volatile("s_nop 1" : "+v"(CA[0]), "+v"(CA[1]));
      mla_pack(CA, pfO); S.l = mla_rowsum(pfO); }
    MLA_BAR();
#define MLA_DSTEP(t_, TP_) do { const int t__ = (t_); const int tk0 = t__ + 4 < NT ? t__ + 4 : NT - 1, tk1 = t__ + 5 < NT ? t__ + 5 : NT - 1, tv0 = t__ + 2 < NT ? t__ + 2 : NT - 1, tv1 = t__ + 3 < NT ? t__ + 3 : NT - 1; \
        mla_step<true, true, true, true, true, false, TP_>(t__ - 1, qw0, qi, lk0, lv0, qf, negm, o, S, CA, CB, pfO, pfE, vpre, G, lkw, lkr, lvw, \
            bK + (size_t)tk0 * (64 * 1024 * 2), bK + (size_t)tk1 * (64 * 1024 * 2), bR + (size_t)tk0 * (64 * 32 * 2), bR + (size_t)tk1 * (64 * 32 * 2), bV + (size_t)tv0 * (64 * 1024 * 2), bV + (size_t)tv1 * (64 * 1024 * 2), voK, voR, hi); \
        mla_step<true, true, true, false, false, true, TP_ + 1>(t__, qw0, qi, lk0, lv0, qf, negm, o, S, CB, CA, pfE, pfO, vpre, G, lkw, lkr, lvw, bK, bK, bR, bR, bV, bV, 0u, 0u, hi); \
        MLA_BAR(); } while (0)
    MLA_DSTEP(2, 2);
#pragma unroll 1
    for (int t = 4; t < NT; t += 4) { MLA_DSTEP(t, 0); MLA_DSTEP(t + 2, 2); }
    mla_step<false, true, true, false, true, false, 0>(NT - 1, qw0, qi, lk0, lv0, qf, negm, o, S, CA, CB, pfO, pfE, vpre, G, lkw, lkr, lvw, bK, bK, bR, bR, bV, bV, 0u, 0u, hi);
    mla_step<false, true, false, false, false, true, 1>(NT, qw0, qi, lk0, lv0, qf, negm, o, S, CB, CA, pfE, pfO, vpre, G, lkw, lkr, lvw, bK, bK, bR, bR, bV, bV, 0u, 0u, hi);
#undef MLA_DSTEP
#undef MLA_LDK
#undef MLA_LDV
#undef MLA_LDR
#undef MLA_BAR
    float l = S.l; l += __shfl_xor(l, 32); const float inv = frcp(l);
#pragma unroll
    for (int dvb = 0; dvb < 2; ++dvb)
#pragma unroll
        for (int g = 0; g < 4; ++g) { const int v = 32 * dvb + 8 * g + 4 * hi; u32x2 w; w.x = cvt_pk_bf16(o[dvb][4 * g] * inv, o[dvb][4 * g + 1] * inv); w.y = cvt_pk_bf16(o[dvb][4 * g + 2] * inv, o[dvb][4 * g + 3] * inv);
            *(u32x2*)(MIX + (rowb + qi) * 1024 + h * 64 + v) = w; }
    __syncthreads();
}

constexpr int SW_STR = 144, SW_WAVE_BYTES = 2 * 32 * SW_STR;
constexpr int SWA_ROWS = 384, SWA_VOFF = SWA_ROWS * SW_STR, SWA_UNITS = 8 * 3 * 64;
__device__ __forceinline__ void swa_unit_decode(int u, int& b, int& head, int& br, int& dsh, int& rho, int& ib) {
    const int bh = u / 192, rem = u - bh * 192; b = bh >> 2; head = bh & 3; br = rem >> 6; const int j64 = rem & 63;
    dsh = 2 * br; rho = j64 >> (6 - dsh); ib = 256 * (j64 & ((64 >> dsh) - 1));
}
__device__ __forceinline__ void swa_phase(const Frame& F) {
    int tid_ = F.tid; asm volatile("" : "+v"(tid_));
    unsigned char* ws = F.ws; const int tid = tid_, lane = tid & 63, wid = F.wave;
    const bf16_t* PROJ = (const bf16_t*)(ws + WS_PROJ); bf16_t* SWO = (bf16_t*)(ws + WS_SWO); float* SWL = (float*)(ws + WS_SWL);
    const int r = lane & 31, hi = lane >> 5, blk = (lane >> 4) & 1, q = (lane & 15) >> 2, pp = lane & 3;
    LAS unsigned char* Lk = F.lds; LAS unsigned char* Lv = F.lds + SWA_VOFF;
    const int srow = tid >> 3, sch = tid & 7;
    const int vcu = (F.G % 8 == 0) ? (F.bx % 8) * (F.G / 8) + F.bx / 8 : F.bx;
    u32x4 rk[6], rv[6];
#define SWA_ISSUE(u_) do { int b_, head_, br_, dsh_, rho_, ib_; swa_unit_decode((u_), b_, head_, br_, dsh_, rho_, ib_); \
        _Pragma("unroll") for (int i = 0; i < 6; ++i) { int ik = ib_ - 128 + srow + 64 * i; ik = ik < 0 ? 0 : ik; \
            const bf16_t* src = PROJ + ((size_t)b_ * SEQ + rho_ + ((size_t)ik << dsh_)) * D_INP + head_ * 64 + sch * 8; rk[i] = *(const u32x4*)(src + C_SWK); rv[i] = *(const u32x4*)(src + C_SWV); } } while (0)
    f32x16 biasLo, biasHi;
    { const int d = r - 4 * hi;
#pragma unroll
      for (int reg = 0; reg < 16; ++reg) { const int c = (reg & 3) + 8 * (reg >> 2); biasLo[reg] = c < d ? -1e30f : 0.f; biasHi[reg] = c > d ? -1e30f : 0.f; } }
    const bool xl = F.G == 256; const int ustep = xl ? 32 : F.G, uend = xl ? (F.bx % 8) * 192 + 192 : SWA_UNITS;
    int u = xl ? (F.bx % 8) * 192 + F.bx / 8 : vcu;
    if (u < uend) SWA_ISSUE(u);
#pragma unroll 1
    for (; u < uend; u += ustep) {
        int b, head, br, dsh, rho, ib; swa_unit_decode(u, b, head, br, dsh, rho, ib);
        const size_t rowb = (size_t)b * SEQ;
        const int iq = ib + 32 * wid + r; const size_t tokq = rowb + rho + ((size_t)iq << dsh);
        bf16x8 qf[4];
#pragma unroll
        for (int s4 = 0; s4 < 4; ++s4) qf[s4] = *(const bf16x8*)(PROJ + tokq * D_INP + C_SWQ + head * 64 + 16 * s4 + 8 * hi);
#pragma unroll
        for (int i = 0; i < 6; ++i) { *(LAS u32x4*)(Lk + (srow + 64 * i) * SW_STR + sch * 16) = rk[i]; *(LAS u32x4*)(Lv + (srow + 64 * i) * SW_STR + sch * 16) = rv[i]; }
        __syncthreads();
        if (u + ustep < uend) SWA_ISSUE(u + ustep);
        f32x16 st[5];
#pragma unroll
        for (int tau = 0; tau < 5; ++tau) {
            const int lrow = 32 * wid + 32 * tau;
            f32x16 acc = tau == 0 ? biasLo : (tau == 4 ? biasHi : f32x16{});
#pragma unroll
            for (int s4 = 0; s4 < 4; ++s4) { const bf16x8 A = *(const LAS bf16x8*)(Lk + (lrow + r) * SW_STR + (16 * s4 + 8 * hi) * 2); acc = __builtin_amdgcn_mfma_f32_32x32x16_bf16(A, qf[s4], acc, 0, 0, 0); }
            st[tau] = acc;
        }
        if (ib < 128) {
#pragma unroll
            for (int tau = 0; tau < 5; ++tau) { const int e = ib - 128 + 32 * wid + 32 * tau + 4 * hi;
#pragma unroll
                for (int reg = 0; reg < 16; ++reg) { const int c = (reg & 3) + 8 * (reg >> 2); st[tau][reg] = (c + e < 0) ? -1e30f : st[tau][reg]; } }
        }
        float mxa = max3f(st[0][0], st[0][1], st[0][2]), mxb = max3f(st[0][3], st[0][4], st[0][5]);
#pragma unroll
        for (int i = 6; i < 80; i += 4) { mxa = max3f(mxa, st[i >> 4][i & 15], st[(i + 1) >> 4][(i + 1) & 15]); if (i + 2 < 80) mxb = max3f(mxb, st[(i + 2) >> 4][(i + 2) & 15], st[(i + 3) >> 4][(i + 3) & 15]); }
        const float m = swapmax32(fmaxf(mxa, mxb));
        float s0 = 0.f, s1 = 0.f; f32x16 o[2] = {{}, {}};
#pragma unroll
        for (int tau = 0; tau < 5; ++tau) {
            const LAS unsigned char* vt = Lv + (32 * wid + 32 * tau) * SW_STR;
#pragma unroll
            for (int sp = 0; sp < 2; ++sp) {
                u32x4 pw;
#pragma unroll
                for (int j = 0; j < 8; ++j) st[tau][8 * sp + j] = fexp2(st[tau][8 * sp + j] - m);
                asm volatile("s_nop 0" : "+v"(st[tau]));
                pw.x = cvt_pk_bf16(st[tau][8 * sp + 0], st[tau][8 * sp + 1]); pw.y = cvt_pk_bf16(st[tau][8 * sp + 2], st[tau][8 * sp + 3]);
                pw.z = cvt_pk_bf16(st[tau][8 * sp + 4], st[tau][8 * sp + 5]); pw.w = cvt_pk_bf16(st[tau][8 * sp + 6], st[tau][8 * sp + 7]);
                s0 = dot2ones(pw.x, s0); s1 = dot2ones(pw.y, s1); s0 = dot2ones(pw.z, s0); s1 = dot2ones(pw.w, s1);
                const bf16x8 P = __builtin_bit_cast(bf16x8, pw);
#pragma unroll
                for (int dvb = 0; dvb < 2; ++dvb) { const LAS unsigned char* pa = vt + (16 * sp + 4 * hi + q) * SW_STR + (32 * dvb + 16 * blk + 4 * pp) * 2;
                    const bf16x8 A = cat4(tr_read(pa), tr_read(pa + 8 * SW_STR));
                    o[dvb] = __builtin_amdgcn_mfma_f32_32x32x16_bf16(A, P, o[dvb], 0, 0, 0); }
            }
        }
        const float l = s0 + s1;
        const float lt = l + __shfl_xor(l, 32); const float inv = frcp(lt);
#pragma unroll
        for (int dvb = 0; dvb < 2; ++dvb)
#pragma unroll
            for (int g = 0; g < 4; ++g) { const int v = 32 * dvb + 8 * g + 4 * hi; u32x2 w; w.x = cvt_pk_bf16(o[dvb][4 * g] * inv, o[dvb][4 * g + 1] * inv); w.y = cvt_pk_bf16(o[dvb][4 * g + 2] * inv, o[dvb][4 * g + 3] * inv);
                *(u32x2*)(SWO + ((size_t)br * T + tokq) * 256 + head * 64 + v) = w; }
        if (hi == 0) SWL[((size_t)br * T + tokq) * 4 + head] = m + flog2(lt);
        __syncthreads();
    }
#undef SWA_ISSUE
}
__device__ __forceinline__ void swa_merge_phase(const Frame& F, int skip) {
    unsigned char* ws = F.ws; const bf16_t* SWO = (const bf16_t*)(ws + WS_SWO); const float* SWL = (const float*)(ws + WS_SWL); bf16_t* MIX = (bf16_t*)*(float* const CAS*)(F.kp + 192);
    if (F.bx < skip) return;
    for (int it = (F.bx - skip) * 512 + F.tid; it < T * 32; it += (F.G - skip) * 512) {
        const int row = it >> 3, c8 = it & 7; const size_t tok = (size_t)(row >> 2); const int head = row & 3;
        const u32x4 a0 = *(const u32x4*)(SWO + ((size_t)0 * T + tok) * 256 + head * 64 + c8 * 8), a1 = *(const u32x4*)(SWO + ((size_t)1 * T + tok) * 256 + head * 64 + c8 * 8), a2 = *(const u32x4*)(SWO + ((size_t)2 * T + tok) * 256 + head * 64 + c8 * 8);
        const float l0 = SWL[((size_t)0 * T + tok) * 4 + head], l1 = SWL[((size_t)1 * T + tok) * 4 + head], l2 = SWL[((size_t)2 * T + tok) * 4 + head];
        const float M = fmaxf(l0, fmaxf(l1, l2)); float w0 = fexp2(l0 - M), w1 = fexp2(l1 - M), w2 = fexp2(l2 - M); const float iw = 1.0f / (w0 + w1 + w2); w0 *= iw; w1 *= iw; w2 *= iw;
        u32x4 ow;
        ow.x = cvt_pk_bf16(w0 * bflo(a0.x) + w1 * bflo(a1.x) + w2 * bflo(a2.x), w0 * bfhi(a0.x) + w1 * bfhi(a1.x) + w2 * bfhi(a2.x));
        ow.y = cvt_pk_bf16(w0 * bflo(a0.y) + w1 * bflo(a1.y) + w2 * bflo(a2.y), w0 * bfhi(a0.y) + w1 * bfhi(a1.y) + w2 * bfhi(a2.y));
        ow.z = cvt_pk_bf16(w0 * bflo(a0.z) + w1 * bflo(a1.z) + w2 * bflo(a2.z), w0 * bfhi(a0.z) + w1 * bfhi(a1.z) + w2 * bfhi(a2.z));
        ow.w = cvt_pk_bf16(w0 * bflo(a0.w) + w1 * bflo(a1.w) + w2 * bflo(a2.w), w0 * bfhi(a0.w) + w1 * bfhi(a1.w) + w2 * bfhi(a2.w));
        *(u32x4*)(MIX + tok * 1024 + 768 + head * 64 + c8 * 8) = ow;
    }
}

#ifndef SITE_MASK
#define SITE_MASK 0xffffffffu
#endif
#ifndef REP_MASK
#define REP_MASK 0u
#endif
#ifndef REP_SWA
#define REP_SWA 1
#endif
#ifndef REP_ML1
#define REP_ML1 1
#endif
#ifndef REP_G2
#define REP_G2 1
#endif
#ifndef REP_ML3
#define REP_ML3 1
#endif
#ifndef REP_MLA
#define REP_MLA 1
#endif
#ifndef MLA_VAR
#define MLA_VAR 0
#endif
#define PHASE_BEGIN(site) if (((SITE_MASK >> (site)) & 1u) && ph >= lo && ph < hi) { Frame F = make_frame(ldsb, wave0); unsigned char* ws = F.ws; LAS unsigned char* xch = F.lds + XCH_OFF; \
        float* OUT = *(float* const CAS*)(F.kp + 192); bf16_t* XB = (bf16_t*)(ws + WS_H); bf16_t* MIX = (bf16_t*)OUT; float* XS = (float*)(ws + WS_XS); bf16_t* PROJ = (bf16_t*)(ws + WS_PROJ); bf16_t* Yb = (bf16_t*)(ws + WS_Y); (void)OUT; (void)XB; (void)MIX; (void)XS; (void)PROJ; (void)Yb; (void)xch; \
        _Pragma("unroll 1") for (int rep_ = 0; rep_ < (((REP_MASK >> (site)) & 1u) ? 2 : 1); ++rep_) {
#define PHASE_END   } if (ph + 1 < hi) { XcdBarrier bar; bar.bar = (unsigned*)(F.ws + WS_CTL) + 1024; bar.x = xb_xcc_id(); bar.st = (volatile LAS unsigned*)(ldsb + MISC_OFF) + 8; bar.wave0 = wave0; xcd_barrier(bar); } } ++ph;

#define BUILD_XATTN_WEIGHTS(l_) do { unsigned char* wb_ = ws + (((l_) & 1) ? WDELTA : 0); \
        { pg8::Gemm g{(const bf16_t*)(ws + WS_MEMK) + (size_t)(l_) * 512 * 1024, (const bf16_t*)(ws + WS_WXQR), 1024, 1024, 256}; pg8::Order<6> S; S.init(8, 4, F.G, F.bx, 1024, 1024); \
          pg8::EpiStore E{(bf16_t*)(wb_ + WS_WQK), 1024, nullptr}; pg8::gemm_phase(F.lds, xch, g, S, E, F.wave); } \
        { pg8::Gemm g{(const bf16_t*)(ws + WS_WXOT), (const bf16_t*)(ws + WS_MEMV) + (size_t)(l_) * 512 * 1024, 1024, 1024, 256}; pg8::Order<7> S; S.init(8, 4, F.G, F.G >= 64 ? (F.bx + F.G - 32) % F.G : F.bx, 1024, 1024); \
          pg8::EpiStore E{(bf16_t*)(wb_ + WS_WVO), 1024, nullptr}; pg8::gemm_phase(F.lds, xch, g, S, E, F.wave); } } while (0)
template <int l> __device__ __forceinline__ void run_layer(LAS unsigned char* const ldsb, const int wave0, int& ph, const int lo, const int hi) {
        PHASE_BEGIN(2)
            pg8::Gemm g{XB, (const bf16_t*)(ws + WS_WIN + ((l & 1) ? WDELTA : 0)), 1024, 1024, 1024}; pg8::Order<0> S; S.init(T / 256, D_INP / 256, F.G, F.bx, 1024, 1024);
            pg8::EpiProj E{PROJ, XS, (bf16_t*)(ws + WS_KPE), (float*)(ws + WS_GATE), (float*)(ws + WS_SSQ), (const float*)(ws + WS_TMC), (const float*)(ws + WS_TMS), (const float*)(ws + WS_TSC), (const float*)(ws + WS_TSS),
                           F.in(9) + l * 4, F.in(10) + l * 4, 0.125f * LOG2E};
            pg8::gemm_phase(F.lds, xch, g, S, E, F.wave);
            if (2 * F.bx >= F.G) {
                Frame Fc = make_frame(ldsb, wave0); Fc.gw = (Fc.bx - Fc.G / 2) * NWAVES + Fc.wave; Fc.NGW = (Fc.G - Fc.G / 2) * NWAVES; convert_ffn_weights(Fc, l); }
        PHASE_END
        PHASE_BEGIN(4)
            _Pragma("unroll 1") for (int rq = 0; rq < REP_G2; ++rq)
            if ((SITE_MASK >> 17) & 1u) { pg8::Gemm g{PROJ + C_CQ, (const bf16_t*)(ws + WS_WUQ + ((l & 1) ? WDELTA : 0)), D_INP, 256, 256}; pg8::Order<0> S; S.init(T / 256, 3, F.G, F.bx, D_INP, 256);
              pg8::EpiQ E{(bf16_t*)(ws + WS_Q), (const float*)(ws + WS_TMC), (const float*)(ws + WS_TMS), 0.10206207261596577f * LOG2E, (const float*)(ws + WS_SSQ)}; pg8::gemm_phase(F.lds, xch, g, S, E, F.wave); }
            _Pragma("unroll 1") for (int rq = 0; rq < REP_G2; ++rq)
            if ((SITE_MASK >> 18) & 1u) { pg8::Gemm g{PROJ + C_CKV, (const bf16_t*)(ws + WS_WUKV + ((l & 1) ? WDELTA : 0)), D_INP, 128, 128}; pg8::Order<0> S; S.init(T / 256, 4, F.G, F.bx, D_INP, 128);
              pg8::EpiStoreKV E{(bf16_t*)(ws + WS_KV), 1024, (const float*)(ws + WS_SSQ)}; pg8::gemm_phase(F.lds, xch, g, S, E, F.wave); }
            if ((SITE_MASK >> 19) & 1u) { _Pragma("unroll 1") for (int rep = 0; rep < REP_ML1; ++rep) ml1_phase(F, F.in(7) + (size_t)l * 4 * 512, F.in(8) + (size_t)l * 512); }
        PHASE_END
        PHASE_BEGIN(5)
            ml2_phase(F);
            if (F.bx >= ML2_WGS) {
            Frame Fc = F; Fc.gw = (F.bx - ML2_WGS) * NWAVES + F.wave; Fc.NGW = (F.G - ML2_WGS) * NWAVES;
            if (l + 1 < DEPTH) convert_attn_weights(Fc, l + 1);
            }
        PHASE_END
        PHASE_BEGIN(6)
            { const int vcu = (F.G % 8 == 0) ? (F.bx % 8) * (F.G / 8) + F.bx / 8 : F.bx;
_Pragma("unroll 1")
              for (int rep = 0; rep < REP_MLA; ++rep)
              for (int p2 = 2 * vcu; p2 < 1024; p2 += ((p2 & 1) ? 2 * F.G - 1 : 1)) { const int p = p2 >> 1, bh = p >> 5, j = p & 31; mla_unit(F, bh >> 3, bh & 7, (p2 & 1) ? 63 - j : j); }
            }
            { const Frame F2 = make_frame(ldsb, wave0);
_Pragma("unroll 1")
              for (int rep = 0; rep < REP_SWA; ++rep) swa_phase(F2); }
            { const Frame F3 = make_frame(ldsb, wave0);
_Pragma("unroll 1")
              for (int rep = 0; rep < REP_ML3; ++rep) ml3_phase(F3); }
        PHASE_END
        PHASE_BEGIN(3)
            swa_merge_phase(F, (l + 1 < DEPTH && F.G >= 128) ? 64 : 0);
            if (l + 1 < DEPTH) BUILD_XATTN_WEIGHTS(l + 1);
        PHASE_END
        PHASE_BEGIN(7)
            pg8::Gemm g{MIX, (const bf16_t*)(ws + WS_WOUT + ((l & 1) ? WDELTA : 0)), 1024, 1024, 1024}; pg8::Order<0> S; S.init(T / 256, 4, F.G, F.bx, 1024, 1024);

#ifdef PROBE_RESID
            { pg8::EpiResidual<false> Ed{(bf16_t*)(ws + 392 * MiB), nullptr, F.in(18) + l * DM, (float*)(ws + 457 * MiB), (float*)(ws + 456 * MiB), (unsigned*)(ws + WS_CTL + WS_CNT + 8192), 4u * (3 * l + 1), XB}; pg8::gemm_phase(F.lds, xch, g, S, Ed, F.wave); }
#endif
            pg8::EpiResidual<false> E{XB, nullptr, F.in(18) + l * DM, (float*)(ws + WS_SL), XS, (unsigned*)(ws + WS_CTL + WS_CNT), 4u * (3 * l + 1)}; pg8::gemm_phase(F.lds, xch, g, S, E, F.wave);
        PHASE_END
        PHASE_BEGIN(9)
            pg8::Gemm g{XB, (const bf16_t*)(ws + WS_WQK + ((l & 1) ? WDELTA : 0)), 1024, 1024, 1024}; pg8::Order<5> S; S.init(T / 256, 4, F.G, F.bx, 1024, 1024);
            pg8::EpiSoftmax E{(bf16_t*)(ws + WS_P), 0.0625f * LOG2E, XS}; pg8::gemm_phase(F.lds, xch, g, S, E, F.wave);
        PHASE_END
        PHASE_BEGIN(12)
            pg8::Gemm g{(const bf16_t*)(ws + WS_P), (const bf16_t*)(ws + WS_WVO + ((l & 1) ? WDELTA : 0)), 1024, 1024, 1024}; pg8::Order<5> S; S.init(T / 256, 4, F.G, F.bx, 1024, 1024);

#ifdef PROBE_RESID
            { pg8::EpiResidual<false> Ed{(bf16_t*)(ws + 392 * MiB), nullptr, F.in(21) + l * DM, (float*)(ws + 457 * MiB), (float*)(ws + 456 * MiB), (unsigned*)(ws + WS_CTL + WS_CNT + 8192), 4u * (3 * l + 2), XB}; pg8::gemm_phase(F.lds, xch, g, S, Ed, F.wave); }
#endif
            pg8::EpiResidual<false> E{XB, nullptr, F.in(21) + l * DM, (float*)(ws + WS_SL), XS, (unsigned*)(ws + WS_CTL + WS_CNT), 4u * (3 * l + 2)}; pg8::gemm_phase(F.lds, xch, g, S, E, F.wave);
        PHASE_END
#ifdef PROBE_G8PHASE
        PHASE_BEGIN(20)
            pg8::Gemm g{XB, (const bf16_t*)(ws + WS_WGU), 1024, 1024, 1024}; pg8::Order<0> S; S.init(T / 256, 22, F.G, F.bx, 1024, 1024);
            pg8::EpiSwiGLU E{(bf16_t*)(ws + 136 * MiB), XS}; pg8::gemm_phase(F.lds, xch, g, S, E, F.wave);
        PHASE_END
#endif
        PHASE_BEGIN(14)
            pg8::Gemm g{XB, (const bf16_t*)(ws + WS_WGU), 1024, 1024, 1024}; pg8::Order<0> S; S.init(T / 256, 22, F.G, F.bx, 1024, 1024);
            pg8::EpiSwiGLU E{(bf16_t*)(ws + WS_ACT), XS}; pg8::gemm_phase(F.lds, xch, g, S, E, F.wave);
        PHASE_END
        PHASE_BEGIN(15)
            pg8::Gemm g{(const bf16_t*)(ws + WS_ACT), (const bf16_t*)(ws + WS_WDN), D_FF, D_FF, D_FF}; pg8::Order<0> S; S.init(T / 256, 4, F.G, F.bx, D_FF, D_FF);
            if (l + 1 < DEPTH) {
#ifdef PROBE_RESID
            { pg8::EpiResidual<false> Ed{(bf16_t*)(ws + 392 * MiB), nullptr, F.in(23) + l * DM, (float*)(ws + 457 * MiB), (float*)(ws + 456 * MiB), (unsigned*)(ws + WS_CTL + WS_CNT + 8192), 4u * (3 * l + 3), XB}; pg8::gemm_phase(F.lds, xch, g, S, Ed, F.wave); }
#endif
            pg8::EpiResidual<false> E{XB, nullptr, F.in(23) + l * DM, (float*)(ws + WS_SL), XS, (unsigned*)(ws + WS_CTL + WS_CNT), 4u * (3 * l + 3)}; pg8::gemm_phase(F.lds, xch, g, S, E, F.wave); }
            else {
#ifdef PROBE_RESID
            { pg8::EpiResidual<false> Ed{(bf16_t*)(ws + 392 * MiB), nullptr, F.in(23) + l * DM, (float*)(ws + 457 * MiB), (float*)(ws + 456 * MiB), (unsigned*)(ws + WS_CTL + WS_CNT + 8192), 4u * (3 * l + 3), XB}; pg8::gemm_phase(F.lds, xch, g, S, Ed, F.wave); }
#endif
            pg8::EpiResidual<true> E{XB, OUT, F.in(23) + l * DM, (float*)(ws + WS_SL), XS, (unsigned*)(ws + WS_CTL + WS_CNT), 4u * (3 * l + 3)}; pg8::gemm_phase(F.lds, xch, g, S, E, F.wave); }
        PHASE_END
}

__global__ void __launch_bounds__(NWAVES * 64, 2) trunk_fwd(Args args) {
    extern __shared__ __attribute__((aligned(16))) unsigned char lds_raw[];
    LAS unsigned char* const ldsb = (LAS unsigned char*)lds_raw;
    { volatile LAS unsigned* MISC = (volatile LAS unsigned*)(ldsb + MISC_OFF);
      if (threadIdx.x < 32) MISC[threadIdx.x] = 0u;
      __syncthreads();
      (void)xcd_barrier_post((unsigned*)(args.ws + WS_CTL) + 1024, MISC + 8); }
    const int wave0 = __builtin_amdgcn_readfirstlane(threadIdx.x >> 6);
    const int lo = args.ph_lo, hi = args.ph_hi;
    int ph = 0;
    PHASE_BEGIN(0)
        convert_attn_weights(F, 0);
        prologue_misc(F);
        resid_init_phase(F, F.in(0), XB, XS);
    PHASE_END
    PHASE_BEGIN(1)
        { pg8::Gemm g{(const bf16_t*)(ws + WS_MEMN), (const bf16_t*)(ws + WS_WXKVT), 1024, 1024, 1024}; pg8::Order<3> S; S.init(8, 4, F.G, F.bx, 1024, 1024);
          pg8::EpiStore E{(bf16_t*)(ws + WS_MEMK), 1024, nullptr}; pg8::gemm_phase(F.lds, xch, g, S, E, F.wave); }
        { pg8::Gemm g{(const bf16_t*)(ws + WS_MEMN), (const bf16_t*)(ws + WS_WXKVT), 1024, 1024, 1024}; pg8::Order<4> S; S.init(8, 4, F.G, F.bx, 1024, 1024);
          pg8::EpiStore E{(bf16_t*)(ws + WS_MEMV), 1024, nullptr}; pg8::gemm_phase(F.lds, xch, g, S, E, F.wave); }
    PHASE_END
    PHASE_BEGIN(17)
        BUILD_XATTN_WEIGHTS(0);
    PHASE_END

    run_layer<0>(ldsb, wave0, ph, lo, hi); run_layer<1>(ldsb, wave0, ph, lo, hi); run_layer<2>(ldsb, wave0, ph, lo, hi); run_layer<3>(ldsb, wave0, ph, lo, hi);
}
#undef PHASE_BEGIN
#undef PHASE_END

#ifndef PH_STOP
#define PH_STOP 1000
#endif
extern "C" void kernel_launch(void* const* d_in, const int* in_sizes, int n_in, void* d_out, int out_size, void* d_ws, size_t ws_size, hipStream_t stream) {
    static int grid = 0;
    if (grid == 0) {
        if (n_in != 24 || out_size != T * DM || ws_size < WS_END) { fprintf(stderr, "kernel_launch: unexpected sizes n_in %d out %d ws %zu\n", n_in, out_size, ws_size); grid = -1; return; }
        int dev = 0, cus = 0, per_cu = 0;
        if (hipGetDevice(&dev) != hipSuccess || hipDeviceGetAttribute(&cus, hipDeviceAttributeMultiprocessorCount, dev) != hipSuccess) { grid = -1; return; }
        if (hipFuncSetAttribute((const void*)trunk_fwd, hipFuncAttributeMaxDynamicSharedMemorySize, LDS_BYTES) != hipSuccess) { fprintf(stderr, "kernel_launch: hipFuncSetAttribute failed\n"); grid = -1; return; }
        if (hipOccupancyMaxActiveBlocksPerMultiprocessor(&per_cu, (const void*)trunk_fwd, NWAVES * 64, LDS_BYTES) != hipSuccess || per_cu < 1) { fprintf(stderr, "kernel_launch: occupancy query says %d\n", per_cu); }
        (void)hipGetLastError();
        grid = cus;
    }
    if (grid < 0) return;
    hipMemsetAsync((char*)d_ws + WS_CTL, 0, CTL_ZERO_BYTES, stream);
    Args a{};
    for (int i = 0; i < 24; ++i) a.in[i] = (const float*)d_in[i];
    a.out = (float*)d_out; a.ws = (unsigned char*)d_ws; a.ph_lo = 0; a.ph_hi = PH_STOP;
    hipLaunchKernelGGL(trunk_fwd, dim3(grid), dim3(NWAVES * 64), LDS_BYTES, stream, a);
}
```

```cpp
#include <hip/hip_runtime.h>
#include <cstdio>
#include <cstdint>

#define LAS __attribute__((address_space(3)))
#define GAS __attribute__((address_space(1)))
typedef unsigned short bf16_t;
typedef short bf16x8 __attribute__((ext_vector_type(8)));
typedef short s16x4 __attribute__((ext_vector_type(4)));
typedef float f32x2 __attribute__((ext_vector_type(2)));
typedef float f32x4 __attribute__((ext_vector_type(4)));
typedef float f32x16 __attribute__((ext_vector_type(16)));
typedef unsigned u32x2 __attribute__((ext_vector_type(2)));
typedef unsigned u32x4 __attribute__((ext_vector_type(4)));
typedef GAS unsigned gu32;

constexpr int DM = 1024, NB = 2, SEQ = 16384, DEPTH = 4, T = NB * SEQ, NMEM = 256;
constexpr int D_IN = 2216, D_INP = 2304, D_FF = 2816;
constexpr float EPS = 1e-6f;
constexpr float LOG2E = 1.4426950408889634f;
constexpr int C_CQ = 0, C_CKV = 256, C_KR = 384, C_GATE = 416, C_MLQ = 512, C_MLK = 768, C_MLV = 1024, C_MLO = 1280, C_SWQ = 1536, C_SWK = 1792, C_SWV = 2048;
__host__ __device__ __forceinline__ int win_src_col(int n) {
    if (n < 384) return n;
    if (n < 416) { const int c = n - 384; return 384 + 16 * ((c >> 2) & 1) + 4 * (c >> 3) + (c & 3); }
    if (n < 424) return 1440 + (n - 416);
    if (n < 512) return -1;
    if (n < 1536) return 416 + (n - 512);
    if (n < 2048) { const int m = n - 1536, t = m >> 8, hh = (m >> 6) & 3, c = m & 63; const int dim = c < 16 ? 8 * ((c >> 2) & 1) + 4 * (c >> 3) + (c & 3) : c; return 1448 + t * 256 + hh * 64 + dim; }
    return 1960 + (n - 2048);
}

constexpr size_t MiB = 1u << 20;
constexpr size_t WS_CTL = 0, CTL_ZERO_BYTES = 64 * 1024;
constexpr size_t WS_TMC = 1 * MiB, WS_TMS = 2 * MiB, WS_TSC = 3 * MiB, WS_TSS = 3 * MiB + 512 * 1024;
constexpr size_t WS_WIN = 4 * MiB;
constexpr size_t WS_WUQ = WS_WIN + (size_t)D_INP * 1024 * 2;
constexpr size_t WS_WUKV = WS_WUQ + 768 * 256 * 2;
constexpr size_t WS_WOUT = WS_WUKV + 1024 * 128 * 2;
constexpr size_t WS_WQK = WS_WOUT + 2 * MiB;
constexpr size_t WS_WVO = WS_WQK + 4 * MiB;
static_assert(WS_WVO + 4 * MiB <= 20 * MiB, "attention-side weights");
constexpr size_t WS_WGU = 20 * MiB;
constexpr size_t WS_WDN = WS_WGU + 11 * MiB;
static_assert(WS_WDN + (size_t)1024 * 2816 * 2 <= 40 * MiB, "ffn weights");
constexpr size_t WS_MEMK = 490 * MiB;
constexpr size_t WS_MEMV = 494 * MiB;
constexpr size_t WS_WXQR = 498 * MiB;
constexpr size_t WS_WXOT = 500 * MiB;
constexpr size_t WS_KPE = 40 * MiB;
constexpr size_t WS_GATE = 42 * MiB;
constexpr size_t WS_MLB = 43 * MiB;
constexpr size_t WS_MLM = 43 * MiB + 16 * 1024;
constexpr size_t WS_RSTD = 43 * MiB + 64 * 1024;
constexpr size_t WS_MLU = 44 * MiB;
constexpr size_t WS_MLC = 61 * MiB;
constexpr size_t WS_MLN = 69 * MiB;
constexpr size_t WS_SWL = 70 * MiB;
constexpr size_t WS_H = 72 * MiB;
constexpr size_t WS_BIG = 136 * MiB;
constexpr size_t WS_PROJ = WS_BIG;
constexpr size_t WS_Q = 280 * MiB;
constexpr size_t WS_KV = 328 * MiB;
constexpr size_t WS_MLQK = 392 * MiB;
constexpr size_t WS_SWO = 424 * MiB;
constexpr size_t WS_Y = WS_BIG;
constexpr size_t WS_P = 264 * MiB;
constexpr size_t WS_ACT = 200 * MiB;
constexpr size_t WS_WXKVT = WS_BIG;
constexpr size_t WS_MEMN = WS_BIG + 16 * MiB;
constexpr size_t WS_SSQ = 472 * MiB;
constexpr size_t WS_SL = 473 * MiB;
constexpr size_t WS_XS = 473 * MiB + 512 * 1024;
constexpr size_t WS_CNT = 32 * 1024;
constexpr size_t WS_W2ND = 474 * MiB;
constexpr size_t WDELTA = WS_W2ND - WS_WIN;
constexpr size_t WS_END = 502 * MiB;
static_assert(WS_ACT + (size_t)T * D_FF * 2 <= WS_END, "act");

constexpr int RING_BYTES = 131072;
constexpr int XCH_OFF = RING_BYTES;
constexpr int MISC_OFF = XCH_OFF + 8192;
constexpr int LDS_BYTES = 147456;
constexpr int NWAVES = 8;

__device__ __forceinline__ unsigned cvt_pk_bf16(float lo, float hi) { unsigned r; asm volatile("v_cvt_pk_bf16_f32 %0, %1, %2" : "=v"(r) : "v"(lo), "v"(hi)); return r; }
__device__ __forceinline__ float bf2f(unsigned short b) { return __uint_as_float(((unsigned)b) << 16); }
__device__ __forceinline__ float bflo(unsigned w) { return __uint_as_float(w << 16); }
__device__ __forceinline__ float bfhi(unsigned w) { return __uint_as_float(w & 0xffff0000u); }
__device__ __forceinline__ bf16_t f2bf(float f) { return (bf16_t)(cvt_pk_bf16(f, 0.f) & 0xffffu); }
__device__ __forceinline__ void unpack8(const u32x4 w, float (&v)[8]) { v[0] = bflo(w.x); v[1] = bfhi(w.x); v[2] = bflo(w.y); v[3] = bfhi(w.y); v[4] = bflo(w.z); v[5] = bfhi(w.z); v[6] = bflo(w.w); v[7] = bfhi(w.w); }
__device__ __forceinline__ u32x4 pack8(const float (&v)[8]) { u32x4 w; w.x = cvt_pk_bf16(v[0], v[1]); w.y = cvt_pk_bf16(v[2], v[3]); w.z = cvt_pk_bf16(v[4], v[5]); w.w = cvt_pk_bf16(v[6], v[7]); return w; }
__device__ __forceinline__ float wave_sum(float v) {
#pragma unroll
    for (int o = 1; o < 64; o <<= 1) v += __shfl_xor(v, o);
    return v;
}
__device__ __forceinline__ float fexp2(float x) { return __builtin_amdgcn_exp2f(x); }
__device__ __forceinline__ float flog2(float x) { return __builtin_amdgcn_logf(x); }
__device__ __forceinline__ float frcp(float x) { return __builtin_amdgcn_rcpf(x); }
__device__ __forceinline__ int crow(int reg, int hi) { return (reg & 3) + 8 * (reg >> 2) + 4 * hi; }
__device__ __forceinline__ int hw_lane() { int l; asm volatile("v_mbcnt_lo_u32_b32 %0, -1, 0\n\tv_mbcnt_hi_u32_b32 %0, -1, %0" : "=v"(l)); return l; }
#define LDS_WAIT() asm volatile("s_waitcnt lgkmcnt(0)" ::: "memory")
#define VM_WAIT() asm volatile("s_waitcnt vmcnt(0)" ::: "memory")
__device__ __forceinline__ s16x4 tr_read(const LAS unsigned char* p) {
    typedef short v4i16_t __attribute__((ext_vector_type(4)));
    return __builtin_bit_cast(s16x4, __builtin_amdgcn_ds_read_tr16_b64_v4i16((LAS v4i16_t*)p));
}
__device__ __forceinline__ bf16x8 cat4(s16x4 a, s16x4 b) { return (bf16x8){a[0], a[1], a[2], a[3], b[0], b[1], b[2], b[3]}; }

#define XB_TMO      128
#define XB_XCNT(j)  (256  + 64 * (j))
#define XB_XSUB(j)  (1280 + 64 * (j))
#define XB_XGEN(j)  (2304 + 64 * (j))
#define XB_TOP      3328
#define XB_TOPGEN   3392
#define XCD_BAR_WORDS 3456
#define XB_SPIN_CAP (1u << 22)
__device__ __forceinline__ unsigned xb_ld(unsigned* p)              { return __hip_atomic_load(p, __ATOMIC_RELAXED, __HIP_MEMORY_SCOPE_AGENT); }
__device__ __forceinline__ unsigned xb_add(unsigned* p, unsigned v) { return __hip_atomic_fetch_add(p, v, __ATOMIC_RELAXED, __HIP_MEMORY_SCOPE_AGENT); }
__device__ __forceinline__ unsigned xb_xcc_id() { return (unsigned)__builtin_amdgcn_s_getreg((3 << 11) | 20) & 0xFu; }
#define XB_SPIN(cond, bar) do { unsigned _sp = 0; while (cond) { __builtin_amdgcn_s_sleep(1); \
    if ((++_sp & 255u) == 0u) { if (xb_ld(&(bar)[XB_TMO])) break; if (_sp > XB_SPIN_CAP) { atomicAdd(&(bar)[XB_TMO], 1u); break; } } } } while (0)
struct XcdBarrier { unsigned* bar; unsigned x; volatile LAS unsigned* st; int wave0; };
__device__ __forceinline__ XcdBarrier xcd_barrier_post(unsigned* bar, volatile LAS unsigned* st) {
    XcdBarrier b; b.bar = bar; b.x = xb_xcc_id(); b.st = st;
    if (threadIdx.x == 0) (void)xb_add(&bar[XB_XCNT(b.x)], 1u);
    return b;
}
__device__ __forceinline__ void xcd_barrier_complete(unsigned* bar, unsigned x, unsigned& nloc, unsigned& nx) {
    const unsigned G = gridDim.x * gridDim.y * gridDim.z;
    unsigned sum, cnt, mine, sp = 0u;
    for (;;) {
        sum = 0u; cnt = 0u; mine = 0u;
#pragma unroll
        for (unsigned j = 0; j < 16; ++j) { const unsigned c = xb_ld(&bar[XB_XCNT(j)]); sum += c; cnt += (c > 0u) ? 1u : 0u; mine = (j == x) ? c : mine; }
        if (sum == G) break;
        __builtin_amdgcn_s_sleep(1);
        if ((++sp & 255u) == 0u) { if (xb_ld(&bar[XB_TMO])) break; if (sp > XB_SPIN_CAP) { atomicAdd(&bar[XB_TMO], 1u); break; } }
    }
    nloc = mine > 0u ? mine : 1u; nx = cnt > 0u ? cnt : 1u;
}
__device__ __forceinline__ void xcd_barrier(const XcdBarrier& b) {
    asm volatile("s_waitcnt vmcnt(0)" ::: "memory");
    __syncthreads();
    if (b.wave0 == 0 && hw_lane() == 0) {
        unsigned* bar = b.bar;
        __builtin_amdgcn_s_waitcnt(0);
        unsigned nloc = b.st[0], nx = b.st[1];
        if (nloc == 0u) { xcd_barrier_complete(bar, b.x, nloc, nx); b.st[0] = nloc; b.st[1] = nx; }
        const unsigned old = xb_add(&bar[XB_XSUB(b.x)], 1u);
        const unsigned gen = old / nloc;
        if (old + 1u == (gen + 1u) * nloc) {
            __builtin_amdgcn_fence(__ATOMIC_RELEASE, "agent");
            asm volatile("s_waitcnt vmcnt(0)" ::: "memory");
            const unsigned og = xb_add(&bar[XB_TOP], 1u);
            const unsigned tg = og / nx;
            if (og + 1u == (tg + 1u) * nx) xb_add(&bar[XB_TOPGEN], 1u);
            else XB_SPIN(xb_ld(&bar[XB_TOPGEN]) == tg, bar);
            __builtin_amdgcn_fence(__ATOMIC_ACQUIRE, "agent");
            xb_add(&bar[XB_XGEN(b.x)], 1u);
            asm volatile("s_waitcnt vmcnt(0)" ::: "memory");
        } else {
            XB_SPIN(xb_ld(&bar[XB_XGEN(b.x)]) == gen, bar);
            __builtin_amdgcn_fence(__ATOMIC_ACQUIRE, "agent");
            asm volatile("s_waitcnt vmcnt(0)" ::: "memory");
        }
    }
    __syncthreads();
}

namespace pg8 {
constexpr int BM = 256, BK = 64, HALF = 128, HTB = HALF * BK * 2, STAGE_BYTES = 8 * HTB, NXCD = 8, WGM = 8;
__host__ __device__ __forceinline__ int lds_byte(int r, int c) { const int st = (r >> 4) * 2 + (c >> 5), rr = r & 15, cc = c & 31, ob = rr * 64 + cc * 2; return st * 1024 + (ob ^ (((ob >> 9) & 1) << 5)); }
__host__ __device__ __forceinline__ void stage_rc(int b, int& R, int& C) { const int st = b / 1024, sb = b % 1024, swz = sb ^ (((sb >> 9) & 1) << 5); R = (st >> 1) * 16 + swz / 64; C = (st & 1) * 32 + (swz % 64) / 2; }
__host__ __device__ __forceinline__ int perm32(int rho) { const int n = rho >> 4, i = rho & 15; return 8 * (i >> 2) + 4 * n + (i & 3); }

struct Unit { int pm, pn; size_t aoff, boff; };
struct Gemm { const bf16_t* A; const bf16_t* Bt; int lda, ldb, K; };

__device__ __forceinline__ int xcd_remap(int wgid, int nwg) { const int q = nwg / NXCD, r = nwg % NXCD, xcd = wgid % NXCD, off = wgid / NXCD; return (xcd < r ? xcd * (q + 1) : r * (q + 1) + (xcd - r) * q) + off; }

template <int MODE> struct Order {
    int nM, nN, nwg, G, c, lda, ldb;
    __device__ __forceinline__ void init(int nM_, int nN_, int G_, int c_, int lda_, int ldb_) { nM = nM_; nN = nN_; nwg = nM_ * nN_; G = G_; c = c_; lda = lda_; ldb = ldb_; }
    __device__ __forceinline__ bool next(int i, Unit& u) const {
        const long L = (long)i * G + c; if (L >= nwg) return false;
        const int wgid = xcd_remap((int)L, nwg);
        if (MODE == 0) {
            const int nig = WGM * nN, gid = wgid / nig, fm = gid * WGM, gsz = (nM - fm) < WGM ? (nM - fm) : WGM;
            u.pm = fm + ((wgid % nig) % gsz); u.pn = (wgid % nig) / gsz;
            u.aoff = (size_t)u.pm * BM * lda * 2; u.boff = (size_t)u.pn * BM * ldb * 2;
        } else if (MODE == 1 || MODE == 2) {
            const int bh = wgid >> 6, rt = wgid & 63, b = bh >> 2, h = bh & 3;
            u.pm = b * 64 + rt; u.pn = h;
            u.aoff = ((size_t)u.pm * BM * lda + h * 256) * 2;
            u.boff = (MODE == 1) ? ((size_t)(b * 256) * 1024 + h * 256) * 2 : ((size_t)(b * 1024 + h * 256) * 256) * 2;
        } else if (MODE == 3) {
            u.pm = wgid >> 2; u.pn = wgid & 3;
            u.aoff = (size_t)u.pm * BM * 1024 * 2; u.boff = ((size_t)(u.pm >> 1) * 2048 * 1024 + (size_t)u.pn * BM * 1024) * 2;
        } else if (MODE == 4) {
            u.pm = wgid >> 2; u.pn = wgid & 3;
            u.aoff = (size_t)u.pm * BM * 1024 * 2; u.boff = ((size_t)(u.pm >> 1) * 2048 * 1024 + (size_t)(1024 + u.pn * BM) * 1024) * 2;
        } else if (MODE == 5) {
            const int nig = WGM * nN, gid = wgid / nig, fm = gid * WGM, gsz = (nM - fm) < WGM ? (nM - fm) : WGM;
            u.pm = fm + ((wgid % nig) % gsz); u.pn = (wgid % nig) / gsz;
            u.aoff = (size_t)u.pm * BM * lda * 2; u.boff = ((size_t)(u.pm >> 6) * 1024 + (size_t)u.pn * BM) * ldb * 2;
        } else if (MODE == 6) {
            const int bh = wgid >> 2, ct = wgid & 3, b = bh >> 2, h = bh & 3;
            u.pm = bh; u.pn = ct;
            u.aoff = ((size_t)(b * 256) * 1024 + h * 256) * 2; u.boff = ((size_t)(ct * 256) * 1024 + h * 256) * 2;
        } else {
            const int b = wgid >> 4, h = (wgid >> 2) & 3, rt = wgid & 3;
            u.pm = b * 4 + rt; u.pn = h;
            u.aoff = ((size_t)(rt * 256) * 1024 + h * 256) * 2; u.boff = ((size_t)(b * 256) * 1024 + h * 256) * 2;
        }
        return true;
    }
};

__device__ __forceinline__ float rstd4(const float* p) { const f32x4 v = *(const f32x4*)p; return __builtin_amdgcn_rsqf(((v[0] + v[1]) + (v[2] + v[3])) * (1.0f / DM) + EPS); }
template <int RS> struct EpiStoreT {
    static constexpr bool PERM = true;
    bf16_t* O; int ldc; const float* rs;
    __device__ __forceinline__ void operator()(f32x4 (&acc)[2][2][4][2], const Unit& u, int wr, int wc, int fr, int fq, LAS unsigned char* xch) const {
        const int row0 = u.pm * BM + wr * 64 + fr, col0 = u.pn * BM + wc * 32 + 8 * fq;
#pragma unroll
        for (int ai = 0; ai < 2; ++ai)
#pragma unroll
            for (int m = 0; m < 4; ++m) { bf16_t* rowp = O + (size_t)(row0 + ai * HALF + m * 16) * ldc + col0; float sc = 1.0f;
                if (RS == 0) asm volatile("" : "+v"(sc));
                if (RS == 1) sc = rstd4(rs + (size_t)(row0 + ai * HALF + m * 16) * 4);
                if (RS == 2) { const f32x4 p4 = *(const f32x4*)(rs + (size_t)(row0 + ai * HALF + m * 16) * 8 + 4); sc = __builtin_amdgcn_rsqf(((p4[0] + p4[1]) + (p4[2] + p4[3])) * (1.0f / 128.f) + EPS); }
#pragma unroll
                for (int bj = 0; bj < 2; ++bj) { const f32x4 v0 = acc[ai][bj][m][0] * sc, v1 = acc[ai][bj][m][1] * sc;
                    u32x4 w; w.x = cvt_pk_bf16(v0[0], v0[1]); w.y = cvt_pk_bf16(v0[2], v0[3]); w.z = cvt_pk_bf16(v1[0], v1[1]); w.w = cvt_pk_bf16(v1[2], v1[3]);
                    *(u32x4*)(rowp + bj * HALF) = w; } }
    }
};
typedef EpiStoreT<0> EpiStore;
typedef EpiStoreT<1> EpiStoreRS;
typedef EpiStoreT<2> EpiStoreKV;
struct EpiQ {
    static constexpr bool PERM = false;
    bf16_t* O; const float* tcos; const float* tsin; float scale; const float* ssq;
    __device__ __forceinline__ void operator()(f32x4 (&acc)[2][2][4][2], const Unit& u, int wr, int wc, int fr, int fq, LAS unsigned char* xch) const {
#pragma unroll
        for (int ai = 0; ai < 2; ++ai)
#pragma unroll
            for (int m = 0; m < 4; ++m) {
                const int row = u.pm * BM + ai * HALF + wr * 64 + m * 16 + fr, pos = row & (SEQ - 1);
                const f32x4 p4 = *(const f32x4*)(ssq + (size_t)row * 8); const float rsc = scale * __builtin_amdgcn_rsqf(((p4[0] + p4[1]) + (p4[2] + p4[3])) * (1.0f / 256.f) + EPS);
#pragma unroll
                for (int bj = 0; bj < 2; ++bj) {
                    const int g = 8 * u.pn + 4 * bj + wc;
                    f32x4 x1 = acc[ai][bj][m][0], x2 = acc[ai][bj][m][1];
                    if ((g % 3) == 2) {
                        const f32x4 c = *(const f32x4*)(tcos + pos * 16 + 4 * fq), s = *(const f32x4*)(tsin + pos * 16 + 4 * fq);
                        const f32x4 o1 = x1 * c - x2 * s, o2 = x2 * c + x1 * s; x1 = o1; x2 = o2;
                    }
                    x1 = x1 * rsc; x2 = x2 * rsc;
                    bf16_t* p = O + (size_t)row * 768 + g * 32 + 4 * fq;
                    u32x2 w1, w2; w1.x = cvt_pk_bf16(x1[0], x1[1]); w1.y = cvt_pk_bf16(x1[2], x1[3]); w2.x = cvt_pk_bf16(x2[0], x2[1]); w2.y = cvt_pk_bf16(x2[2], x2[3]);
                    *(u32x2*)p = w1; *(u32x2*)(p + 16) = w2;
                }
            }
    }
};
struct EpiSwiGLU {
    static constexpr bool PERM = true;
    bf16_t* O; const float* rs;
    __device__ __forceinline__ void operator()(f32x4 (&acc)[2][2][4][2], const Unit& u, int wr, int wc, int fr, int fq, LAS unsigned char* xch) const {
        const int row0 = u.pm * BM + wr * 64 + fr, col0 = u.pn * HALF + wc * 32 + 8 * fq;
#pragma unroll
        for (int ai = 0; ai < 2; ++ai)
#pragma unroll
            for (int m = 0; m < 4; ++m) {
                float a[8]; const float sc = rstd4(rs + (size_t)(row0 + ai * HALF + m * 16) * 4);
#pragma unroll
                for (int n = 0; n < 2; ++n)
#pragma unroll
                    for (int j = 0; j < 4; ++j) { const float g = acc[ai][0][m][n][j] * sc, up = acc[ai][1][m][n][j] * sc; a[n * 4 + j] = g * frcp(1.f + fexp2(-g * LOG2E)) * up; }
                u32x4 w; w.x = cvt_pk_bf16(a[0], a[1]); w.y = cvt_pk_bf16(a[2], a[3]); w.z = cvt_pk_bf16(a[4], a[5]); w.w = cvt_pk_bf16(a[6], a[7]);
                *(u32x4*)(O + (size_t)(row0 + ai * HALF + m * 16) * D_FF + col0) = w;
            }
    }
};
struct EpiProj {
    static constexpr bool PERM = true;
    bf16_t* O; const float* rs; bf16_t* KPE; float* GATE; float* SSQ; const float* tmc; const float* tms; const float* tsc; const float* tss; const float* bi; const float* bf; float qs;
    __device__ __forceinline__ void operator()(f32x4 (&acc)[2][2][4][2], const Unit& u, int wr, int wc, int fr, int fq, LAS unsigned char* xch) const {
        const int row0 = u.pm * BM + wr * 64 + fr, col0 = u.pn * BM + wc * 32 + 8 * fq, pn = u.pn;
#pragma unroll
        for (int ai = 0; ai < 2; ++ai)
#pragma unroll
            for (int m = 0; m < 4; ++m) {
                const int row = row0 + ai * HALF + m * 16, pos = row & (SEQ - 1); const float sc = rstd4(rs + (size_t)row * 4);
                bf16_t* rowp = O + (size_t)row * D_INP + col0;
                f32x4 v[2][2];
#pragma unroll
                for (int bj = 0; bj < 2; ++bj) { v[bj][0] = acc[ai][bj][m][0] * sc; v[bj][1] = acc[ai][bj][m][1] * sc; }
                if (pn <= 1) {
                    float ss = 0.f;
#pragma unroll
                    for (int bj = 0; bj < 2; ++bj) if (pn == 0 || bj == 0) {
#pragma unroll
                        for (int n = 0; n < 2; ++n) ss += (v[bj][n][0] * v[bj][n][0] + v[bj][n][1] * v[bj][n][1]) + (v[bj][n][2] * v[bj][n][2] + v[bj][n][3] * v[bj][n][3]); }
                    ss += __shfl_xor(ss, 16); ss += __shfl_xor(ss, 32);
                    if (fq == 0) SSQ[(size_t)row * 8 + 4 * pn + wc] = ss;
                }
                if (pn == 1) {
                    if (wc == 0) {
                        const f32x4 c = *(const f32x4*)(tmc + pos * 16 + 4 * fq), s = *(const f32x4*)(tms + pos * 16 + 4 * fq);
                        const f32x4 o1 = v[1][0] * c - v[1][1] * s, o2 = v[1][1] * c + v[1][0] * s;
                        u32x2 w1, w2; w1.x = cvt_pk_bf16(o1[0], o1[1]); w1.y = cvt_pk_bf16(o1[2], o1[3]); w2.x = cvt_pk_bf16(o2[0], o2[1]); w2.y = cvt_pk_bf16(o2[2], o2[3]);
                        *(u32x2*)(KPE + (size_t)row * 32 + 4 * fq) = w1; *(u32x2*)(KPE + (size_t)row * 32 + 16 + 4 * fq) = w2;
                    } else if (wc == 1 && fq == 0) {
                        f32x4 li, lf;
#pragma unroll
                        for (int j = 0; j < 4; ++j) { li[j] = v[1][0][j] + bi[j]; const float z = v[1][1][j] + bf[j]; lf[j] = fminf(z, 0.f) - log1pf(expf(-fabsf(z))); }
                        *(f32x4*)(GATE + (size_t)row * 8) = li; *(f32x4*)(GATE + (size_t)row * 8 + 4) = lf;
                    }
                }
                if (pn == 6 || pn == 7) {
                    if ((wc & 1) == 0 && fq < 2) {
                        const f32x4 c = *(const f32x4*)(tsc + pos * 8 + 4 * fq), s = *(const f32x4*)(tss + pos * 8 + 4 * fq);
#pragma unroll
                        for (int bj = 0; bj < 2; ++bj) { const f32x4 o1 = v[bj][0] * c - v[bj][1] * s, o2 = v[bj][1] * c + v[bj][0] * s; v[bj][0] = o1; v[bj][1] = o2; }
                    }
                    if (pn == 6) {
#pragma unroll
                        for (int bj = 0; bj < 2; ++bj) { v[bj][0] = v[bj][0] * qs; v[bj][1] = v[bj][1] * qs; } }
                }
#pragma unroll
                for (int bj = 0; bj < 2; ++bj) {
                    if (pn == 1 && bj == 1) continue;
                    u32x4 w; w.x = cvt_pk_bf16(v[bj][0][0], v[bj][0][1]); w.y = cvt_pk_bf16(v[bj][0][2], v[bj][0][3]); w.z = cvt_pk_bf16(v[bj][1][0], v[bj][1][1]); w.w = cvt_pk_bf16(v[bj][1][2], v[bj][1][3]);
                    *(u32x4*)(rowp + bj * HALF) = w; }
            }
    }
};
template <bool LAST> struct EpiResidual {
    static constexpr bool PERM = true;
    bf16_t* XB; float* OUT; const float* g; float* SL; float* XS; unsigned* cnt; unsigned target; const bf16_t* XBld = nullptr;
    __device__ __forceinline__ void operator()(f32x4 (&acc)[2][2][4][2], const Unit& u, int wr, int wc, int fr_, int fq_, LAS unsigned char* xch) const {
        LAS float* XP = (LAS float*)xch; LAS float* RS = (LAS float*)(xch + 4096);
        int fr = fr_, fq = fq_; asm volatile("" : "+v"(fr), "+v"(fq));
        const int t = (wr * 4 + wc) * 64 + fq * 16 + fr;
        const int col0 = u.pn * BM + wc * 32 + 8 * fq;
        u32x4 xw[2][4][2];
#pragma unroll
        for (int ai = 0; ai < 2; ++ai)
#pragma unroll
            for (int m = 0; m < 4; ++m)
#pragma unroll
                for (int bj = 0; bj < 2; ++bj) xw[ai][m][bj] = *(const u32x4*)((XBld ? XBld : XB) + ((size_t)u.pm * BM + ai * HALF + wr * 64 + m * 16 + fr) * DM + col0 + bj * HALF);
#pragma unroll
        for (int ai = 0; ai < 2; ++ai)
#pragma unroll
            for (int m = 0; m < 4; ++m) { float ss = 0.f;
#pragma unroll
                for (int bj = 0; bj < 2; ++bj)
#pragma unroll
                    for (int n = 0; n < 2; ++n) { const f32x4 v = acc[ai][bj][m][n]; ss += (v[0] * v[0] + v[1] * v[1]) + (v[2] * v[2] + v[3] * v[3]); }
                ss += __shfl_xor(ss, 16); ss += __shfl_xor(ss, 32);
                if (fq == 0) XP[(ai * HALF + wr * 64 + m * 16 + fr) * 4 + wc] = ss; }
        asm volatile("s_waitcnt lgkmcnt(0)" ::: "memory"); __builtin_amdgcn_s_barrier(); asm volatile("" ::: "memory");
        if (t < 256) { const f32x4 p4 = *(const LAS f32x4*)(XP + t * 4);
            __hip_atomic_store((unsigned*)(SL + ((size_t)u.pm * BM + t) * 4 + u.pn), __float_as_uint((p4[0] + p4[1]) + (p4[2] + p4[3])), __ATOMIC_RELAXED, __HIP_MEMORY_SCOPE_AGENT); }
        asm volatile("s_waitcnt vmcnt(0)" ::: "memory"); __builtin_amdgcn_s_barrier(); asm volatile("" ::: "memory");
        if (t == 0) { unsigned* c = cnt + u.pm * 16; (void)__hip_atomic_fetch_add(c, 1u, __ATOMIC_RELAXED, __HIP_MEMORY_SCOPE_AGENT);
            unsigned sp = 0; while (__hip_atomic_load(c, __ATOMIC_RELAXED, __HIP_MEMORY_SCOPE_AGENT) < target) { __builtin_amdgcn_s_sleep(1); if (++sp > (1u << 22)) break; } }
        asm volatile("s_waitcnt vmcnt(0) lgkmcnt(0)" ::: "memory"); __builtin_amdgcn_s_barrier(); asm volatile("" ::: "memory");
        if (t < 256) { const unsigned* s4 = (const unsigned*)(SL + ((size_t)u.pm * BM + t) * 4);
            const float a = __uint_as_float(__hip_atomic_load(s4 + 0, __ATOMIC_RELAXED, __HIP_MEMORY_SCOPE_AGENT)), b = __uint_as_float(__hip_atomic_load(s4 + 1, __ATOMIC_RELAXED, __HIP_MEMORY_SCOPE_AGENT)),
                        c = __uint_as_float(__hip_atomic_load(s4 + 2, __ATOMIC_RELAXED, __HIP_MEMORY_SCOPE_AGENT)), d = __uint_as_float(__hip_atomic_load(s4 + 3, __ATOMIC_RELAXED, __HIP_MEMORY_SCOPE_AGENT));
            RS[t] = __builtin_amdgcn_rsqf(((a + b) + (c + d)) * (1.0f / DM) + EPS); }
        asm volatile("s_waitcnt vmcnt(0) lgkmcnt(0)" ::: "memory"); __builtin_amdgcn_s_barrier(); asm volatile("" ::: "memory");
        f32x4 gv[2][2];
#pragma unroll
        for (int bj = 0; bj < 2; ++bj) { gv[bj][0] = *(const f32x4*)(g + col0 + bj * HALF); gv[bj][1] = *(const f32x4*)(g + col0 + bj * HALF + 4); }
#pragma unroll
        for (int ai = 0; ai < 2; ++ai)
#pragma unroll
            for (int m = 0; m < 4; ++m) {
                const int rl = ai * HALF + wr * 64 + m * 16 + fr; const size_t grow = (size_t)u.pm * BM + rl; const float rstd = RS[rl]; float ss2 = 0.f;
#pragma unroll
                for (int bj = 0; bj < 2; ++bj) {
                    float x[8]; unpack8(xw[ai][m][bj], x);
                    const f32x4 y0 = acc[ai][bj][m][0] * rstd * gv[bj][0], y1 = acc[ai][bj][m][1] * rstd * gv[bj][1];
                    x[0] += y0[0]; x[1] += y0[1]; x[2] += y0[2]; x[3] += y0[3]; x[4] += y1[0]; x[5] += y1[1]; x[6] += y1[2]; x[7] += y1[3];
                    if (LAST) { float* po = OUT + grow * DM + col0 + bj * HALF; *(f32x4*)po = (f32x4){x[0], x[1], x[2], x[3]}; *(f32x4*)(po + 4) = (f32x4){x[4], x[5], x[6], x[7]}; }
                    else { *(u32x4*)(XB + grow * DM + col0 + bj * HALF) = pack8(x);
#pragma unroll
                        for (int e = 0; e < 8; ++e) ss2 += x[e] * x[e]; }
                }
                if (!LAST) { ss2 += __shfl_xor(ss2, 16); ss2 += __shfl_xor(ss2, 32); if (fq == 0) XP[rl * 4 + wc] = ss2; }
            }
        if (!LAST) {
            asm volatile("s_waitcnt lgkmcnt(0)" ::: "memory"); __builtin_amdgcn_s_barrier(); asm volatile("" ::: "memory");
            if (t < 256) { const f32x4 p4 = *(const LAS f32x4*)(XP + t * 4); XS[((size_t)u.pm * BM + t) * 4 + u.pn] = (p4[0] + p4[1]) + (p4[2] + p4[3]); }
        }
        asm volatile("s_waitcnt lgkmcnt(0)" ::: "memory"); __builtin_amdgcn_s_barrier(); asm volatile("" ::: "memory");
    }
};
struct EpiSoftmax {
    static constexpr bool PERM = true;
    bf16_t* O; float scale2; const float* rs;
    __device__ __forceinline__ void operator()(f32x4 (&acc)[2][2][4][2], const Unit& u, int wr, int wc, int fr, int fq, LAS unsigned char* xch) const {
        LAS f32x2* X = (LAS f32x2*)xch;
#pragma unroll
        for (int ai = 0; ai < 2; ++ai)
#pragma unroll
            for (int m = 0; m < 4; ++m) {
                float mx = -3.0e38f; const float sc2 = scale2 * rstd4(rs + (size_t)(u.pm * BM + ai * HALF + wr * 64 + m * 16 + fr) * 4);
#pragma unroll
                for (int bj = 0; bj < 2; ++bj)
#pragma unroll
                    for (int n = 0; n < 2; ++n) { f32x4 v = acc[ai][bj][m][n] * sc2; acc[ai][bj][m][n] = v; mx = fmaxf(mx, fmaxf(fmaxf(v[0], v[1]), fmaxf(v[2], v[3]))); }
                mx = fmaxf(mx, __shfl_xor(mx, 16)); mx = fmaxf(mx, __shfl_xor(mx, 32));
                float sm = 0.f;
#pragma unroll
                for (int bj = 0; bj < 2; ++bj)
#pragma unroll
                    for (int n = 0; n < 2; ++n) { f32x4 v = acc[ai][bj][m][n]; v[0] = fexp2(v[0] - mx); v[1] = fexp2(v[1] - mx); v[2] = fexp2(v[2] - mx); v[3] = fexp2(v[3] - mx); acc[ai][bj][m][n] = v; sm += (v[0] + v[1]) + (v[2] + v[3]); }
                sm += __shfl_xor(sm, 16); sm += __shfl_xor(sm, 32);
                if (fq == 0) X[(ai * HALF + wr * 64 + m * 16 + fr) * 4 + wc] = (f32x2){mx, sm};
            }
        asm volatile("s_waitcnt lgkmcnt(0)" ::: "memory"); __builtin_amdgcn_s_barrier(); asm volatile("" ::: "memory");
        const int row0 = u.pm * BM + wr * 64 + fr, col0 = u.pn * BM + wc * 32 + 8 * fq;
#pragma unroll
        for (int ai = 0; ai < 2; ++ai)
#pragma unroll
            for (int m = 0; m < 4; ++m) {
                const int rl = ai * HALF + wr * 64 + m * 16 + fr;
                const f32x2 a = X[rl * 4 + 0], b = X[rl * 4 + 1], c = X[rl * 4 + 2], d = X[rl * 4 + 3];
                const float M = fmaxf(fmaxf(a.x, b.x), fmaxf(c.x, d.x));
                const float tot = a.y * fexp2(a.x - M) + b.y * fexp2(b.x - M) + c.y * fexp2(c.x - M) + d.y * fexp2(d.x - M);
                const f32x2 mine = X[rl * 4 + wc];
                const float f = fexp2(mine.x - M) * frcp(tot);
                bf16_t* rowp = O + (size_t)(row0 + ai * HALF + m * 16) * 1024 + col0;
#pragma unroll
                for (int bj = 0; bj < 2; ++bj) { const f32x4 v0 = acc[ai][bj][m][0] * f, v1 = acc[ai][bj][m][1] * f;
                    u32x4 w; w.x = cvt_pk_bf16(v0[0], v0[1]); w.y = cvt_pk_bf16(v0[2], v0[3]); w.z = cvt_pk_bf16(v1[0], v1[1]); w.w = cvt_pk_bf16(v1[2], v1[3]);
                    *(u32x4*)(rowp + bj * HALF) = w; }
            }
        asm volatile("s_waitcnt lgkmcnt(0)" ::: "memory"); __builtin_amdgcn_s_barrier(); asm volatile("" ::: "memory");
    }
};

template <class Epi, class Sched>
__device__ __forceinline__ void gemm_phase(LAS unsigned char* lds, LAS unsigned char* xch, const Gemm g, const Sched& S, const Epi& E, int wave0) {
    const int ln_ = hw_lane();
    int wid_ = wave0; asm volatile("" : "+s"(wid_));
    const int wid = wid_, lane = ln_, tid = wid * 64 + lane, wr = wid >> 2, wc = wid & 3, fr = lane & 15, fq = lane >> 4;
    int K_ = g.K; asm volatile("" : "+s"(K_));
    const int K = K_, nt = K / BK;
    unsigned voffA[2], voffB[2];
#pragma unroll
    for (int i = 0; i < 2; ++i) { int R, C; stage_rc(tid * 16 + i * 8192, R, C); const int Rb = Epi::PERM ? ((R & ~31) + perm32(R & 31)) : R;
        voffA[i] = (unsigned)(R * g.lda + C) * 2u; voffB[i] = (unsigned)(Rb * g.ldb + C) * 2u; }
    const size_t kstep = (size_t)(BK * 2);
    const size_t hsA = (size_t)HALF * g.lda * 2, hsB = (size_t)HALF * g.ldb * 2;
    const unsigned ldsw = (unsigned)wid * 1024u;
    const int aoff = lds_byte(wr * 64 + fr, fq * 8), boff = lds_byte(wc * 32 + fr, fq * 8);
#define PG8_SA(b, h) (((b) * 2 + (h)) * HTB)
#define PG8_SB(b, h) ((4 + (b) * 2 + (h)) * HTB)
#define PG8_STAGE(bufoff, gbase, voff) do { _Pragma("unroll") for (int _i = 0; _i < 2; ++_i) \
        __builtin_amdgcn_global_load_lds((const unsigned*)((const char*)(gbase) + (voff)[_i]), (LAS unsigned*)(lds + (bufoff) + ldsw + _i * 8192), 16, 0, 0); } while (0)
#define PG8_LDA(dst, b, h) do { _Pragma("unroll") for (int m = 0; m < 4; ++m) _Pragma("unroll") for (int k = 0; k < 2; ++k) dst[m][k] = *(const LAS bf16x8*)(lds + PG8_SA(b, h) + aoff + m * 2048 + k * 1024); } while (0)
#define PG8_LDB(dst, b, h) do { _Pragma("unroll") for (int n = 0; n < 2; ++n) _Pragma("unroll") for (int k = 0; k < 2; ++k) dst[n][k] = *(const LAS bf16x8*)(lds + PG8_SB(b, h) + boff + n * 2048 + k * 1024); } while (0)
#define PG8_MMA(ai, bj, At, Bt) do { __builtin_amdgcn_s_setprio(1); _Pragma("unroll") for (int m = 0; m < 4; ++m) _Pragma("unroll") for (int n = 0; n < 2; ++n) _Pragma("unroll") for (int k = 0; k < 2; ++k) \
        acc[ai][bj][m][n] = __builtin_amdgcn_mfma_f32_16x16x32_bf16(Bt[n][k], At[m][k], acc[ai][bj][m][n], 0, 0, 0); __builtin_amdgcn_s_setprio(0); } while (0)
#define PG8_WAIT_V(n) asm volatile("s_waitcnt vmcnt(" #n ")" ::: "memory")
#define PG8_WAIT_L(n) asm volatile("s_waitcnt lgkmcnt(" #n ")" ::: "memory")
#define PG8_BAR __builtin_amdgcn_s_barrier()
#define PG8_SCHED __builtin_amdgcn_sched_barrier(0)
    Unit cur, nxt; int ui = 0;
    if (!S.next(0, cur)) return;
    f32x4 acc[2][2][4][2];
#pragma unroll
    for (int a = 0; a < 2; ++a)
#pragma unroll
        for (int b = 0; b < 2; ++b)
#pragma unroll
            for (int m = 0; m < 4; ++m)
#pragma unroll
                for (int n = 0; n < 2; ++n) acc[a][b][m][n] = (f32x4){0.f, 0.f, 0.f, 0.f};
    bf16x8 At[4][2], B0[2][2], B1[2][2];
    const char* cA = (const char*)g.A + cur.aoff; const char* cB = (const char*)g.Bt + cur.boff;
    PG8_STAGE(PG8_SB(0, 0), cB, voffB); PG8_STAGE(PG8_SB(0, 1), cB + hsB, voffB); PG8_STAGE(PG8_SA(0, 0), cA, voffA); PG8_STAGE(PG8_SA(0, 1), cA + hsA, voffA);
    if (wr == 1) PG8_BAR;
    PG8_WAIT_V(2); PG8_BAR;
    PG8_STAGE(PG8_SB(1, 0), cB + kstep, voffB); PG8_STAGE(PG8_SA(1, 0), cA + kstep, voffA); PG8_STAGE(PG8_SB(1, 1), cB + hsB + kstep, voffB);
    PG8_WAIT_V(6); PG8_BAR;
    for (;;) {
        const bool has_next = S.next(ui + 1, nxt);
        const char* nA = has_next ? (const char*)g.A + nxt.aoff : cA; const char* nB = has_next ? (const char*)g.Bt + nxt.boff : cB;
#pragma unroll 1
        for (int t = 0; t < nt; t += 2) {
            const bool last = (t == nt - 2);
            const char* a1 = cA + (size_t)(t + 1) * kstep;
            const char* a2 = last ? nA : cA + (size_t)(t + 2) * kstep; const char* b2 = last ? nB : cB + (size_t)(t + 2) * kstep;
            const char* a3 = a2 + kstep; const char* b3 = b2 + kstep;
            PG8_LDB(B0, 0, 0); PG8_LDB(B1, 0, 1); PG8_SCHED; PG8_LDA(At, 0, 0); PG8_STAGE(PG8_SA(1, 1), a1 + hsA, voffA);
            PG8_WAIT_V(8); PG8_WAIT_L(0); PG8_BAR; PG8_MMA(0, 0, At, B0); PG8_MMA(0, 1, At, B1); PG8_BAR; PG8_SCHED;
            PG8_LDA(At, 0, 1); PG8_STAGE(PG8_SB(0, 0), b2, voffB); PG8_STAGE(PG8_SB(0, 1), b2 + hsB, voffB); PG8_STAGE(PG8_SA(0, 0), a2, voffA);
            PG8_WAIT_V(8); PG8_WAIT_L(0); PG8_BAR; PG8_MMA(1, 0, At, B0); PG8_MMA(1, 1, At, B1); PG8_BAR; PG8_SCHED;
            PG8_LDB(B0, 1, 0); PG8_LDB(B1, 1, 1); PG8_SCHED; PG8_LDA(At, 1, 0); PG8_STAGE(PG8_SA(0, 1), a2 + hsA, voffA);
            PG8_WAIT_V(8); PG8_WAIT_L(0); PG8_BAR; PG8_MMA(0, 0, At, B0); PG8_MMA(0, 1, At, B1); PG8_BAR; PG8_SCHED;
            PG8_LDA(At, 1, 1); PG8_STAGE(PG8_SB(1, 0), b3, voffB); PG8_STAGE(PG8_SB(1, 1), b3 + hsB, voffB); PG8_STAGE(PG8_SA(1, 0), a3, voffA);
            PG8_WAIT_V(8); PG8_WAIT_L(0); PG8_BAR; PG8_MMA(1, 0, At, B0); PG8_MMA(1, 1, At, B1); PG8_BAR; PG8_SCHED;
        }
        if (wr == 0) PG8_BAR;
        E(acc, cur, wr, wc, fr, fq, xch);
        if (!has_next) break;
#pragma unroll
        for (int a = 0; a < 2; ++a)
#pragma unroll
            for (int b = 0; b < 2; ++b)
#pragma unroll
                for (int m = 0; m < 4; ++m)
#pragma unroll
                    for (int n = 0; n < 2; ++n) acc[a][b][m][n] = (f32x4){0.f, 0.f, 0.f, 0.f};
        cur = nxt; cA = nA; cB = nB; ++ui;
        if (wr == 1) PG8_BAR;
    }
    PG8_WAIT_V(0);
    PG8_BAR;
#undef PG8_SA
#undef PG8_SB
#undef PG8_STAGE
#undef PG8_LDA
#undef PG8_LDB
#undef PG8_MMA
#undef PG8_WAIT_V
#undef PG8_WAIT_L
#undef PG8_BAR
#undef PG8_SCHED
}
}

struct Args { const float* in[24]; float* out; unsigned char* ws; int ph_lo, ph_hi; };
#define CAS __attribute__((address_space(4)))
struct Frame {
    const CAS unsigned char* kp;
    LAS unsigned char* lds;
    int tid, lane, wave, G, bx, gw, NGW;
    unsigned char* ws;
    __device__ __forceinline__ const float* in(int k) const { return *(const float* const CAS*)(kp + 8 * k); }
};
__device__ __forceinline__ Frame make_frame(LAS unsigned char* lds, int wave0) {
    Frame F;
    const CAS unsigned char* kp = (const CAS unsigned char*)__builtin_amdgcn_kernarg_segment_ptr(); asm volatile("" : "+s"(kp));
    F.kp = kp; F.lds = lds;
    const int ln = hw_lane();
    int wv = wave0; asm volatile("" : "+s"(wv));
    F.lane = ln; F.wave = wv; F.tid = wv * 64 + ln;
    int bx = blockIdx.x, G = gridDim.x; asm volatile("" : "+s"(bx), "+s"(G));
    F.bx = bx; F.G = G; F.gw = bx * NWAVES + F.wave; F.NGW = G * NWAVES;
    F.ws = *(unsigned char* const CAS*)(kp + 200);
    return F;
}

template <bool WINMAP = false>
__device__ __forceinline__ void transpose_item(const float* W, int ldw, int K, int k0, int sc0, int nvalid, bf16_t* Wt, int dr0, LAS float* scr, int lane, const float* kgain = nullptr) {
    if (WINMAP) {
        const int jj = lane & 31; const int scol = win_src_col(dr0 + jj);
#pragma unroll 8
        for (int i = 0; i < 32; ++i) { const int kk = 2 * i + (lane >> 5), j = lane & 31; float w = (scol >= 0) ? W[(size_t)(k0 + kk) * ldw + scol] : 0.f; if (kgain) w *= kgain[k0 + kk]; scr[kk * 33 + j] = w; }
    } else {
        const int n4 = (lane & 7) * 4;
#pragma unroll
        for (int i = 0; i < 8; ++i) { const int kk = (lane >> 3) + 8 * i; f32x4 w = *(const f32x4*)(W + (size_t)(k0 + kk) * ldw + sc0 + n4); if (kgain) w = w * kgain[k0 + kk];
            scr[kk * 33 + n4] = w[0]; scr[kk * 33 + n4 + 1] = w[1]; scr[kk * 33 + n4 + 2] = w[2]; scr[kk * 33 + n4 + 3] = w[3]; }
    }
    LDS_WAIT();
    const int c = lane & 7;
#pragma unroll
    for (int j = 0; j < 4; ++j) { const int n = (lane >> 3) + 8 * j; const LAS float* s = scr + (8 * c) * 33 + n;
        u32x4 o; o.x = cvt_pk_bf16(s[0 * 33], s[1 * 33]); o.y = cvt_pk_bf16(s[2 * 33], s[3 * 33]); o.z = cvt_pk_bf16(s[4 * 33], s[5 * 33]); o.w = cvt_pk_bf16(s[6 * 33], s[7 * 33]);
        *(u32x4*)(Wt + (size_t)(dr0 + n) * K + k0 + 8 * c) = o; }
    LDS_WAIT();
}
__device__ __forceinline__ void convert_rows_item(const float* W, const float* gain, bf16_t* D, int row, int lane) {
    const float g = gain[row];
#pragma unroll
    for (int j = 0; j < 2; ++j) { const float* p = W + (size_t)row * 1024 + 8 * lane + 512 * j; const f32x4 a = *(const f32x4*)p, b = *(const f32x4*)(p + 4);
        const float v[8] = {a[0] * g, a[1] * g, a[2] * g, a[3] * g, b[0] * g, b[1] * g, b[2] * g, b[3] * g}; *(u32x4*)(D + (size_t)row * 1024 + 8 * lane + 512 * j) = pack8(v); }
}
__device__ __forceinline__ void convert_attn_weights(const Frame& F, int l) {
    LAS float* scr = (LAS float*)(F.lds + F.wave * 16384);
    unsigned char* ws = F.ws + ((l & 1) ? WDELTA : 0);
    constexpr int I_IN = 72 * 16, I_UQ = 24 * 4, I_UKV = 32 * 2, I_SQ = 32 * 16, I_R = 1024;
    constexpr int NIT = I_IN + I_UQ + I_UKV + 2 * I_SQ + I_R;
    for (int it = F.gw; it < NIT; it += F.NGW) {
        int r = it;
        if (r < I_IN) { const int nb = r % 72, kb = r / 72, n0 = nb * 32;
            const bool mapped = (n0 >= 384 && n0 < 512) || (n0 >= 1536 && n0 < 2048 && ((n0 - 1536) & 63) == 0);
            if (mapped) transpose_item<true>(F.in(2) + (size_t)l * 1024 * D_IN, D_IN, 1024, kb * 64, 0, 32, (bf16_t*)(ws + WS_WIN), n0, scr, F.lane, F.in(17) + l * DM);
            else transpose_item(F.in(2) + (size_t)l * 1024 * D_IN, D_IN, 1024, kb * 64, win_src_col(n0), 32, (bf16_t*)(ws + WS_WIN), n0, scr, F.lane, F.in(17) + l * DM);
            continue; } r -= I_IN;
        if (r < I_UQ) { const int nb = r % 24, kb = r / 24;
            transpose_item(F.in(4) + (size_t)l * 256 * 768, 768, 256, kb * 64, nb * 32, 32, (bf16_t*)(ws + WS_WUQ), nb * 32, scr, F.lane, F.in(3) + l * 256); continue; } r -= I_UQ;
        if (r < I_UKV) { const int nb = r % 32, kb = r / 32, n0 = nb * 32; const int isv = n0 >= 512, nn = n0 - isv * 512, sc = (nn >> 6) * 128 + isv * 64 + (nn & 63);
            transpose_item(F.in(6) + (size_t)l * 128 * 1024, 1024, 128, kb * 64, sc, 32, (bf16_t*)(ws + WS_WUKV), n0, scr, F.lane, F.in(5) + l * 128); continue; } r -= I_UKV;
        if (r < 2 * I_SQ) { const int which = r / I_SQ, rr = r % I_SQ, nb = rr % 32, kb = rr / 32;
            const float* src = (which == 0 ? F.in(11) : F.in(14)) + (size_t)l * 1024 * 1024;
            bf16_t* dst = which == 0 ? (bf16_t*)(ws + WS_WOUT) : (bf16_t*)(F.ws + WS_WXOT);
            transpose_item(src, 1024, 1024, kb * 64, nb * 32, 32, dst, nb * 32, scr, F.lane); continue; } r -= 2 * I_SQ;
        convert_rows_item(F.in(12) + (size_t)l * 1024 * 1024, F.in(20) + l * DM, (bf16_t*)(F.ws + WS_WXQR), r, F.lane);
    }
}
__device__ __forceinline__ void convert_ffn_weights(const Frame& F, int l) {
    LAS float* scr = (LAS float*)(F.lds + F.wave * 16384);
    unsigned char* ws = F.ws;
    constexpr int I_GU = 176 * 16, I_DN = 32 * 44;
    for (int it = F.gw; it < I_GU + I_DN; it += F.NGW) {
        int r = it;
        if (r < I_GU) { const int nb = r % 176, kb = r / 176, n0 = nb * 32; const int tile = n0 >> 8, bj = (n0 >> 7) & 1, cc = n0 & 127, sc = bj * D_FF + tile * 128 + cc;
            transpose_item(F.in(15) + (size_t)l * 1024 * 2 * D_FF, 2 * D_FF, 1024, kb * 64, sc, 32, (bf16_t*)(ws + WS_WGU), n0, scr, F.lane, F.in(22) + l * DM); continue; } r -= I_GU;
        { const int nb = r % 32, kb = r / 32;
            transpose_item(F.in(16) + (size_t)l * D_FF * 1024, 1024, D_FF, kb * 64, nb * 32, 32, (bf16_t*)(ws + WS_WDN), nb * 32, scr, F.lane); }
    }
}

__device__ __forceinline__ void resid_init_phase(const Frame& F, const float* xin, bf16_t* XB, float* RSTD) {
    for (int row = F.gw; row < T; row += F.NGW) {
        float ss = 0.f;
#pragma unroll
        for (int j = 0; j < 2; ++j) { const float* p = xin + (size_t)row * DM + 8 * F.lane + 512 * j; const f32x4 a = *(const f32x4*)p, b = *(const f32x4*)(p + 4);
            const float v[8] = {a[0], a[1], a[2], a[3], b[0], b[1], b[2], b[3]};
#pragma unroll
            for (int e = 0; e < 8; ++e) ss += v[e] * v[e];
            *(u32x4*)(XB + (size_t)row * DM + 8 * F.lane + 512 * j) = pack8(v); }
        ss = wave_sum(ss);
        if (F.lane == 0) *(f32x4*)(RSTD + (size_t)row * 4) = (f32x4){ss, 0.f, 0.f, 0.f};
    }
}
constexpr int RN_ROWS = 4;
template <bool LAST>
__device__ __forceinline__ void resid_phase(const Frame& F, bf16_t* XB, const bf16_t* Y, const float* gpost, float* RSTD, float* OUT) {
    float g[2][8];
#pragma unroll
    for (int j = 0; j < 2; ++j)
#pragma unroll
        for (int e = 0; e < 8; ++e) g[j][e] = gpost[8 * F.lane + 512 * j + e];
    for (int row0 = F.gw; row0 < T; row0 += RN_ROWS * F.NGW) {
        u32x4 yw[RN_ROWS][2], xw[RN_ROWS][2];
#pragma unroll
        for (int rr = 0; rr < RN_ROWS; ++rr) { const int row = (row0 + rr * F.NGW < T) ? row0 + rr * F.NGW : row0;
#pragma unroll
            for (int j = 0; j < 2; ++j) { yw[rr][j] = *(const u32x4*)(Y + (size_t)row * DM + 8 * F.lane + 512 * j); xw[rr][j] = *(const u32x4*)(XB + (size_t)row * DM + 8 * F.lane + 512 * j); } }
#pragma unroll
        for (int rr = 0; rr < RN_ROWS; ++rr) { const int row = row0 + rr * F.NGW; if (row >= T) break;
            float yv[2][8], xv[2][8]; float ss = 0.f;
#pragma unroll
            for (int j = 0; j < 2; ++j) { unpack8(yw[rr][j], yv[j]); unpack8(xw[rr][j], xv[j]);
#pragma unroll
                for (int e = 0; e < 8; ++e) ss += yv[j][e] * yv[j][e]; }
            const float rstd = 1.0f / sqrtf(wave_sum(ss) * (1.0f / DM) + EPS);
            float s2 = 0.f;
#pragma unroll
            for (int j = 0; j < 2; ++j) {
#pragma unroll
                for (int e = 0; e < 8; ++e) { xv[j][e] += yv[j][e] * rstd * g[j][e]; s2 += xv[j][e] * xv[j][e]; }
                if (LAST) { float* p = OUT + (size_t)row * DM + 8 * F.lane + 512 * j; *(f32x4*)p = (f32x4){xv[j][0], xv[j][1], xv[j][2], xv[j][3]}; *(f32x4*)(p + 4) = (f32x4){xv[j][4], xv[j][5], xv[j][6], xv[j][7]}; }
                else *(u32x4*)(XB + (size_t)row * DM + 8 * F.lane + 512 * j) = pack8(xv[j]); }
            if (!LAST) { s2 = wave_sum(s2); if (F.lane == 0) RSTD[row] = 1.0f / sqrtf(s2 * (1.0f / DM) + EPS); }
        }
    }
}

__device__ __forceinline__ void prologue_misc(const Frame& F) {
    unsigned char* ws = F.ws;
    { const int gt = F.bx * 512 + F.tid, NT_ = F.G * 512;
      float* tmc = (float*)(ws + WS_TMC); float* tms = (float*)(ws + WS_TMS); float* tsc = (float*)(ws + WS_TSC); float* tss = (float*)(ws + WS_TSS);
      for (int e = gt; e < SEQ * 24; e += NT_) {
          const int pos = e / 24, k = e % 24; const bool mla = k < 16; const int i = mla ? k : k - 16; const float drot = mla ? 32.f : 16.f;
          const float inv = (float)pow(500000.0, -(double)(2 * i) / (double)drot);
          const float ang = (float)pos * inv;
          const double ad = (double)ang; const float c = (float)cos(ad), s = (float)sin(ad);
          if (mla) { tmc[pos * 16 + i] = c; tms[pos * 16 + i] = s; } else { tsc[pos * 8 + i] = c; tss[pos * 8 + i] = s; }
      } }
    for (int rr = F.gw; rr < DEPTH * 512; rr += F.NGW) {
        const int l = rr >> 9, row = rr & 511; f32x4 v[4]; float ss = 0.f;
#pragma unroll
        for (int j = 0; j < 4; ++j) { v[j] = *(const f32x4*)(F.in(1) + (size_t)row * DM + 4 * F.lane + 256 * j); ss += (v[j][0] * v[j][0] + v[j][1] * v[j][1]) + (v[j][2] * v[j][2] + v[j][3] * v[j][3]); }
        const float rstd = 1.0f / sqrtf(wave_sum(ss) * (1.0f / DM) + EPS);
#pragma unroll
        for (int j = 0; j < 4; ++j) { const f32x4 g = *(const f32x4*)(F.in(19) + (size_t)l * DM + 4 * F.lane + 256 * j); const f32x4 h = v[j] * rstd * g; u32x2 w; w.x = cvt_pk_bf16(h[0], h[1]); w.y = cvt_pk_bf16(h[2], h[3]);
            *(u32x2*)((bf16_t*)(ws + WS_MEMN) + (size_t)rr * DM + 4 * F.lane + 256 * j) = w; }
    }
    { LAS float* scr = (LAS float*)(F.lds + F.wave * 16384);
      for (int it = F.gw; it < DEPTH * 64 * 16; it += F.NGW) { const int l = it / 1024, rr = it % 1024, nb = rr % 64, kb = rr / 64;
          transpose_item(F.in(13) + (size_t)l * 1024 * 2048, 2048, 1024, kb * 64, nb * 32, 32, (bf16_t*)(ws + WS_WXKVT) + (size_t)l * 2048 * 1024, nb * 32, scr, F.lane); } }
}

__device__ __forceinline__ float wave_scan_sum(float v, int lane) {
#pragma unroll
    for (int o = 1; o < 64; o <<= 1) { const float t = __shfl_up(v, o); if (lane >= o) v += t; }
    return v;
}
__device__ __forceinline__ float wave_scan_max(float v, int lane) {
#pragma unroll
    for (int o = 1; o < 64; o <<= 1) { const float t = __shfl_up(v, o); if (lane >= o) v = fmaxf(v, t); }
    return v;
}
constexpr int ML_STR = 144;
constexpr int ML_GRP_BYTES = 49152;
constexpr int ML_K = 0, ML_V = 18432, ML_C = 36864, ML_F = 46080;

__device__ __forceinline__ void ml1_phase(const Frame& F, const float* convw, const float* convb) {
    unsigned char* ws = F.ws; const int lane = F.lane, grp = F.wave >> 2, gwv = F.wave & 3, gt = F.tid & 255;
    const bf16_t* PROJ = (const bf16_t*)(ws + WS_PROJ); bf16_t* MLQK = (bf16_t*)(ws + WS_MLQK); const float* GATE = (const float*)(ws + WS_GATE);
    float* MLU = (float*)(ws + WS_MLU); float* MLB = (float*)(ws + WS_MLB);
    LAS unsigned char* L = F.lds + grp * ML_GRP_BYTES; LAS float* fs = (LAS float*)(L + ML_F);
    const int r = lane & 31, hi = lane >> 5, blk = (lane >> 4) & 1, q = (lane & 15) >> 2, pp = lane & 3;
    for (int it = 0; ; ++it) {
        const int pair = it * F.G + F.bx; if (pair >= 512) break;
        const int chunk = pair * 2 + grp, bh = chunk >> 7, c = chunk & 127, b = bh >> 2, head = bh & 3; const size_t tok0 = (size_t)b * SEQ + c * 128;
        u32x4 wq[4][4], wk[4][4], wv[4];
#pragma unroll
        for (int i = 0; i < 4; ++i) { const int s = (gt >> 3) + 32 * i, ch = gt & 7;
#pragma unroll
            for (int j = 0; j < 4; ++j) { const int dp = (c * 128 + s + j - 3 >= 0) ? j - 3 : 0; const bf16_t* p = PROJ + (ptrdiff_t)(tok0 + s + dp) * D_INP + head * 64 + ch * 8;
                wq[i][j] = *(const u32x4*)(p + C_MLQ); wk[i][j] = *(const u32x4*)(p + C_MLK); }
            wv[i] = *(const u32x4*)(PROJ + (tok0 + s) * D_INP + C_MLV + head * 64 + ch * 8); }
        if (gwv == 0) {
            const float lf0 = GATE[(tok0 + lane) * 8 + 4 + head], lf1 = GATE[(tok0 + 64 + lane) * 8 + 4 + head];
            const float li0 = GATE[(tok0 + lane) * 8 + head], li1 = GATE[(tok0 + 64 + lane) * 8 + head];
            const float b0 = wave_scan_sum(lf0, lane); const float carry = __shfl(b0, 63); const float b1 = wave_scan_sum(lf1, lane) + carry;
            const float bL = __shfl(b1, 63);
            const float g0 = bL - b0 + li0, g1 = bL - b1 + li1;
            float mx = fmaxf(g0, g1);
#pragma unroll
            for (int o = 1; o < 64; o <<= 1) mx = fmaxf(mx, __shfl_xor(mx, o));
            fs[lane] = expf(g0 - mx); fs[64 + lane] = expf(g1 - mx);
            if (lane == 0) { MLB[chunk * 2] = bL; MLB[chunk * 2 + 1] = mx; }
        }
        __syncthreads();
#pragma unroll
        for (int qk = 0; qk < 2; ++qk) {
            const int ch = gt & 7, cch = qk * 256 + head * 64 + ch * 8;
            float cw[4][8], cb[8];
#pragma unroll
            for (int j = 0; j < 4; ++j)
#pragma unroll
                for (int e = 0; e < 8; ++e) cw[j][e] = convw[j * 512 + cch + e];
#pragma unroll
            for (int e = 0; e < 8; ++e) cb[e] = convb[cch + e];
            const float ksc = qk ? 0.125f : 1.0f;
#pragma unroll
            for (int i = 0; i < 4; ++i) { const int s = (gt >> 3) + 32 * i;
                float a[8];
#pragma unroll
                for (int e = 0; e < 8; ++e) a[e] = cb[e];
#pragma unroll
                for (int j = 0; j < 4; ++j) { const int dp = j - 3;
                    if (c * 128 + s + dp >= 0) { const u32x4 w = qk ? wk[i][j] : wq[i][j];
                        a[0] += cw[j][0] * bflo(w.x); a[1] += cw[j][1] * bfhi(w.x); a[2] += cw[j][2] * bflo(w.y); a[3] += cw[j][3] * bfhi(w.y);
                        a[4] += cw[j][4] * bflo(w.z); a[5] += cw[j][5] * bfhi(w.z); a[6] += cw[j][6] * bflo(w.w); a[7] += cw[j][7] * bfhi(w.w); } }
#pragma unroll
                for (int e = 0; e < 8; ++e) a[e] = a[e] * frcp(1.f + fexp2(-a[e] * LOG2E)) * ksc;
                const u32x4 kb = pack8(a);
                *(u32x4*)(MLQK + (tok0 + s) * 512 + qk * 256 + head * 64 + ch * 8) = kb;
                if (qk) { const float w = fs[s];
                    u32x4 o; o.x = cvt_pk_bf16(bflo(kb.x) * w, bfhi(kb.x) * w); o.y = cvt_pk_bf16(bflo(kb.y) * w, bfhi(kb.y) * w); o.z = cvt_pk_bf16(bflo(kb.z) * w, bfhi(kb.z) * w); o.w = cvt_pk_bf16(bflo(kb.w) * w, bfhi(kb.w) * w);
                    *(LAS u32x4*)(L + ML_K + s * ML_STR + ch * 16) = o;
                    *(LAS u32x4*)(L + ML_V + s * ML_STR + ch * 16) = wv[i]; }
            }
        }
        __syncthreads();
        { const int vi = gwv >> 1, kj = gwv & 1; f32x16 acc = {};
#pragma unroll
          for (int ks = 0; ks < 8; ++ks) {
              const int row = 16 * ks + 8 * hi + q;
              const LAS unsigned char* pa = L + ML_V + row * ML_STR + (32 * vi + 16 * blk + 4 * pp) * 2;
              const LAS unsigned char* pb = L + ML_K + row * ML_STR + (32 * kj + 16 * blk + 4 * pp) * 2;
              const bf16x8 A = cat4(tr_read(pa), tr_read(pa + 4 * ML_STR)), B = cat4(tr_read(pb), tr_read(pb + 4 * ML_STR));
              acc = __builtin_amdgcn_mfma_f32_32x32x16_bf16(A, B, acc, 0, 0, 0);
          }
          float* U = MLU + (size_t)chunk * 4160;
#pragma unroll
          for (int reg = 0; reg < 16; ++reg) U[(32 * vi + crow(reg, hi)) * 64 + 32 * kj + r] = acc[reg];
        }
        if (gt < 64) { float s = 0.f;
            for (int t = 0; t < 128; ++t) s += bf2f(*(const LAS bf16_t*)(L + ML_K + t * ML_STR + gt * 2));
            MLU[(size_t)chunk * 4160 + 4096 + gt] = s; }
        __syncthreads();
    }
}
constexpr int ML2_WGS = (8 * 4160 + 511) / 512;
__device__ __forceinline__ void ml2_phase(const Frame& F) {
    unsigned char* ws = F.ws;
    const float* MLU = (const float*)(ws + WS_MLU); const float* MLB = (const float*)(ws + WS_MLB);
    bf16_t* MLC = (bf16_t*)(ws + WS_MLC); float* MLN = (float*)(ws + WS_MLN); float* MLM = (float*)(ws + WS_MLM);
    const int gt = F.bx * 512 + F.tid;
    if (gt >= 8 * 4160) return;
    const int bh = gt / 4160, e = gt % 4160;
    float st = 0.f, m = -1e30f;
    for (int c0 = 0; c0 < 128; c0 += 32) {
        float u[32], bl[32], ml[32];
#pragma unroll
        for (int j = 0; j < 32; ++j) { const int chunk = bh * 128 + c0 + j; u[j] = MLU[(size_t)chunk * 4160 + e]; bl[j] = MLB[chunk * 2]; ml[j] = MLB[chunk * 2 + 1]; }
#pragma unroll
        for (int j = 0; j < 32; ++j) { const int chunk = bh * 128 + c0 + j;
            if (e < 4096) MLC[(size_t)chunk * 4096 + e] = f2bf(st); else MLN[chunk * 64 + e - 4096] = st;
            if (e == 0) MLM[chunk] = m;
            const float mn = fmaxf(bl[j] + m, ml[j]);
            st = fexp2((bl[j] + m - mn) * LOG2E) * st + fexp2((ml[j] - mn) * LOG2E) * u[j]; m = mn; }
    }
}
__device__ __forceinline__ void ml3_phase(const Frame& F) {
    unsigned char* ws = F.ws; const int lane = F.lane, grp = F.wave >> 2, gwv = F.wave & 3, gt = F.tid & 255;
    const bf16_t* PROJ = (const bf16_t*)(ws + WS_PROJ); const bf16_t* MLQK = (const bf16_t*)(ws + WS_MLQK); const float* GATE = (const float*)(ws + WS_GATE);
    const bf16_t* MLC = (const bf16_t*)(ws + WS_MLC); const float* MLN = (const float*)(ws + WS_MLN); const float* MLM = (const float*)(ws + WS_MLM);
    bf16_t* MIX = (bf16_t*)*(float* const CAS*)(F.kp + 192);
    LAS unsigned char* L = F.lds + grp * ML_GRP_BYTES; LAS float* fa = (LAS float*)(L + ML_F); LAS float* frt = fa + 128; LAS float* fwi = fa + 256; LAS float* fem = fa + 384; LAS float* fn = fa + 512;
    const int r = lane & 31, hi = lane >> 5, blk = (lane >> 4) & 1, q = (lane & 15) >> 2, pp = lane & 3;
    for (int it = 0; ; ++it) {
        const int pair = it * F.G + F.bx; if (pair >= 512) break;
        const int chunk = pair * 2 + grp, bh = chunk >> 7, c = chunk & 127, b = bh >> 2, head = bh & 3; const size_t tok0 = (size_t)b * SEQ + c * 128;
        if (gwv == 0) {
            const float lf0 = GATE[(tok0 + lane) * 8 + 4 + head], lf1 = GATE[(tok0 + 64 + lane) * 8 + 4 + head];
            const float li0 = GATE[(tok0 + lane) * 8 + head], li1 = GATE[(tok0 + 64 + lane) * 8 + head];
            const float b0 = wave_scan_sum(lf0, lane); const float carry = __shfl(b0, 63); const float b1 = wave_scan_sum(lf1, lane) + carry;
            const float a0 = li0 - b0, a1 = li1 - b1;
            const float p0 = wave_scan_max(a0, lane); const float pc = __shfl(p0, 63); const float p1 = fmaxf(wave_scan_max(a1, lane), pc);
            const float m = MLM[chunk];
            const float mt0 = fmaxf(b0 + m, b0 + p0), mt1 = fmaxf(b1 + m, b1 + p1);
            fa[lane] = a0; fa[64 + lane] = a1; frt[lane] = b0 - mt0; frt[64 + lane] = b1 - mt1;
            fwi[lane] = expf(b0 + m - mt0); fwi[64 + lane] = expf(b1 + m - mt1); fem[lane] = expf(-mt0); fem[64 + lane] = expf(-mt1);
        }
#pragma unroll
        for (int i = 0; i < 4; ++i) { const int id = gt + 256 * i, s = id >> 3, ch = id & 7;
            *(LAS u32x4*)(L + ML_K + s * ML_STR + ch * 16) = *(const u32x4*)(MLQK + (tok0 + s) * 512 + 256 + head * 64 + ch * 8);
            *(LAS u32x4*)(L + ML_V + s * ML_STR + ch * 16) = *(const u32x4*)(PROJ + (tok0 + s) * D_INP + C_MLV + head * 64 + ch * 8); }
#pragma unroll
        for (int i = 0; i < 2; ++i) { const int id = gt + 256 * i, v = id >> 3, ch = id & 7;
            *(LAS u32x4*)(L + ML_C + v * ML_STR + ch * 16) = *(const u32x4*)(MLC + (size_t)chunk * 4096 + v * 64 + ch * 8); }
        if (gt < 64) fn[gt] = MLN[chunk * 64 + gt];
        __syncthreads();
        {
            const int tq = 32 * gwv + r; const size_t tokq = tok0 + tq;
            bf16x8 qf[4]; float qn = 0.f;
#pragma unroll
            for (int s = 0; s < 4; ++s) { qf[s] = *(const bf16x8*)(MLQK + tokq * 512 + head * 64 + 16 * s + 8 * hi);
#pragma unroll
                for (int j = 0; j < 8; ++j) qn += bf2f((unsigned short)qf[s][j]) * fn[16 * s + 8 * hi + j]; }
            qn += __shfl_xor(qn, 32);
            f32x16 acc[2] = {{}, {}};
#pragma unroll
            for (int dvb = 0; dvb < 2; ++dvb)
#pragma unroll
                for (int s = 0; s < 4; ++s) { const bf16x8 A = *(const LAS bf16x8*)(L + ML_C + (32 * dvb + r) * ML_STR + (16 * s + 8 * hi) * 2);
                    acc[dvb] = __builtin_amdgcn_mfma_f32_32x32x16_bf16(A, qf[s], acc[dvb], 0, 0, 0); }
            const float wi = fwi[tq], rt = frt[tq];
            acc[0] = acc[0] * wi; acc[1] = acc[1] * wi;
            float sintra = 0.f;
            for (int kb = 0; kb <= gwv; ++kb) {
                f32x16 st = {};
#pragma unroll
                for (int s = 0; s < 4; ++s) { const bf16x8 A = *(const LAS bf16x8*)(L + ML_K + (32 * kb + r) * ML_STR + (16 * s + 8 * hi) * 2);
                    st = __builtin_amdgcn_mfma_f32_32x32x16_bf16(A, qf[s], st, 0, 0, 0); }
#pragma unroll
                for (int reg = 0; reg < 16; ++reg) { const int c = 32 * kb + (reg & 3) + 8 * (reg >> 2);
                    const float w = (c <= tq - 4 * hi) ? fexp2((rt + fa[c + 4 * hi]) * LOG2E) : 0.f; const float pv = st[reg] * w; st[reg] = pv; sintra += pv; }
#pragma unroll
                for (int sp = 0; sp < 2; ++sp) {
                    u32x4 pw; pw.x = cvt_pk_bf16(st[8 * sp + 0], st[8 * sp + 1]); pw.y = cvt_pk_bf16(st[8 * sp + 2], st[8 * sp + 3]); pw.z = cvt_pk_bf16(st[8 * sp + 4], st[8 * sp + 5]); pw.w = cvt_pk_bf16(st[8 * sp + 6], st[8 * sp + 7]);
                    const bf16x8 P = __builtin_bit_cast(bf16x8, pw);
#pragma unroll
                    for (int dvb = 0; dvb < 2; ++dvb) { const LAS unsigned char* pa = L + ML_V + (32 * kb + 16 * sp + 4 * hi + q) * ML_STR + (32 * dvb + 16 * blk + 4 * pp) * 2;
                        const bf16x8 A = cat4(tr_read(pa), tr_read(pa + 8 * ML_STR));
                        acc[dvb] = __builtin_amdgcn_mfma_f32_32x32x16_bf16(A, P, acc[dvb], 0, 0, 0); }
                }
            }
            sintra += __shfl_xor(sintra, 32);
            const float nq = wi * qn + sintra; const float inv = 1.0f / fmaxf(fabsf(nq), fem[tq]);
#pragma unroll
            for (int dvb = 0; dvb < 2; ++dvb)
#pragma unroll
                for (int g = 0; g < 4; ++g) { const int v = 32 * dvb + 8 * g + 4 * hi;
                    const u32x2 ow = *(const u32x2*)(PROJ + tokq * D_INP + C_MLO + head * 64 + v);
                    const float o0 = bflo(ow.x), o1 = bfhi(ow.x), o2 = bflo(ow.y), o3 = bfhi(ow.y);
                    const float h0 = acc[dvb][4 * g + 0] * inv * frcp(1.f + fexp2(-o0 * LOG2E)), h1 = acc[dvb][4 * g + 1] * inv * frcp(1.f + fexp2(-o1 * LOG2E));
                    const float h2 = acc[dvb][4 * g + 2] * inv * frcp(1.f + fexp2(-o2 * LOG2E)), h3 = acc[dvb][4 * g + 3] * inv * frcp(1.f + fexp2(-o3 * LOG2E));
                    u32x2 w; w.x = cvt_pk_bf16(h0, h1); w.y = cvt_pk_bf16(h2, h3);
                    *(u32x2*)(MIX + tokq * 1024 + 512 + head * 64 + v) = w; }
        }
        __syncthreads();
    }
}

template <int NKB, int VSTR>
__device__ __forceinline__ void softmax_pv(f32x16 (&st)[NKB], const unsigned (&vm)[NKB], bool masked, float& m, float& l, f32x16 (&o)[2], const LAS unsigned char* vt, int hi, int blk, int q, int pp) {
    float mx = -1e30f;
#pragma unroll
    for (int kb = 0; kb < NKB; ++kb)
#pragma unroll
        for (int reg = 0; reg < 16; ++reg) mx = fmaxf(mx, st[kb][reg]);
    mx = fmaxf(mx, __shfl_xor(mx, 32));
    const float mn = fmaxf(m, mx), alpha = fexp2(m - mn);
    m = mn; l *= alpha; o[0] = o[0] * alpha; o[1] = o[1] * alpha;
    float ls = 0.f;
#pragma unroll
    for (int kb = 0; kb < NKB; ++kb)
#pragma unroll
        for (int reg = 0; reg < 16; ++reg) { float p = fexp2(st[kb][reg] - mn); if (masked && !((vm[kb] >> reg) & 1u)) p = 0.f; st[kb][reg] = p; ls += p; }
    l += ls;
#pragma unroll
    for (int kb = 0; kb < NKB; ++kb)
#pragma unroll
        for (int sp = 0; sp < 2; ++sp) {
            u32x4 pw; pw.x = cvt_pk_bf16(st[kb][8 * sp + 0], st[kb][8 * sp + 1]); pw.y = cvt_pk_bf16(st[kb][8 * sp + 2], st[kb][8 * sp + 3]); pw.z = cvt_pk_bf16(st[kb][8 * sp + 4], st[kb][8 * sp + 5]); pw.w = cvt_pk_bf16(st[kb][8 * sp + 6], st[kb][8 * sp + 7]);
            const bf16x8 P = __builtin_bit_cast(bf16x8, pw);
#pragma unroll
            for (int dvb = 0; dvb < 2; ++dvb) { const LAS unsigned char* pa = vt + (32 * kb + 16 * sp + 4 * hi + q) * VSTR + (32 * dvb + 16 * blk + 4 * pp) * 2;
                const bf16x8 A = cat4(tr_read(pa), tr_read(pa + 8 * VSTR));
                o[dvb] = __builtin_amdgcn_mfma_f32_32x32x16_bf16(A, P, o[dvb], 0, 0, 0); }
        }
}

constexpr int MLA_KSTR = 208, MLA_VSTR = 192, MLA_KB = 64 * MLA_KSTR, MLA_VB = 64 * MLA_VSTR, MLA_VOFF = 2 * MLA_KB;
constexpr float MLA_THR = 8.0f, MLA_HEAD = 7.f;
struct MlaState { float m, l; };
typedef __bf16 bf16x2_t __attribute__((ext_vector_type(2)));
__device__ __forceinline__ float dot2ones(unsigned w, float acc) { return __builtin_amdgcn_fdot2_f32_bf16(__builtin_bit_cast(bf16x2_t, w), __builtin_bit_cast(bf16x2_t, 0x3f803f80u), acc, false); }
__device__ __forceinline__ float max3f(float a, float b, float c) { return __builtin_fmaxf(__builtin_fmaxf(a, b), c); }
__device__ __forceinline__ float swapmax32(float v) {
    auto rr = __builtin_amdgcn_permlane32_swap(__float_as_uint(v), __float_as_uint(v), false, false);
    return fmaxf(__uint_as_float(rr[0]), __uint_as_float(rr[1]));
}
__device__ __forceinline__ void mla_mask(int t, int qw0, int qi, int hi, f32x16 (&C)[2]) {
    if (64 * t + 63 > qw0) {
        int d2 = qi - 64 * t - 4 * hi; asm volatile("" : "+v"(d2));
#pragma unroll
        for (int kb = 0; kb < 2; ++kb)
#pragma unroll
            for (int reg = 0; reg < 16; ++reg) C[kb][reg] = (32 * kb + (reg & 3) + 8 * (reg >> 2) > d2) ? -1e30f : C[kb][reg];
    }
}
__device__ __forceinline__ float mla_rowmax(const f32x16 (&C)[2]) {
    float mxa = max3f(C[0][0], C[0][1], C[1][0]), mxb = max3f(C[0][2], C[0][3], C[1][1]); mxa = max3f(mxa, C[1][2], C[1][3]);
#pragma unroll
    for (int reg = 4; reg < 16; reg += 4) { mxa = max3f(mxa, C[0][reg], C[0][reg + 1]); mxb = max3f(mxb, C[0][reg + 2], C[0][reg + 3]); mxa = max3f(mxa, C[1][reg], C[1][reg + 1]); mxb = max3f(mxb, C[1][reg + 2], C[1][reg + 3]); }
    return swapmax32(fmaxf(mxa, mxb));
}
__device__ __forceinline__ void mla_pack(const f32x16 (&P)[2], u32x4 (&pf)[2][2]) {
#pragma unroll
    for (int kb = 0; kb < 2; ++kb)
#pragma unroll
        for (int sp = 0; sp < 2; ++sp) { pf[kb][sp].x = cvt_pk_bf16(P[kb][8 * sp + 0], P[kb][8 * sp + 1]); pf[kb][sp].y = cvt_pk_bf16(P[kb][8 * sp + 2], P[kb][8 * sp + 3]);
            pf[kb][sp].z = cvt_pk_bf16(P[kb][8 * sp + 4], P[kb][8 * sp + 5]); pf[kb][sp].w = cvt_pk_bf16(P[kb][8 * sp + 6], P[kb][8 * sp + 7]); }
}
__device__ __forceinline__ float mla_rowsum(const u32x4 (&pf)[2][2]) {
    float s0 = 0.f, s1 = 0.f;
#pragma unroll
    for (int kb = 0; kb < 2; ++kb)
#pragma unroll
        for (int sp = 0; sp < 2; ++sp) { s0 = dot2ones(pf[kb][sp].x, s0); s1 = dot2ones(pf[kb][sp].y, s1); s0 = dot2ones(pf[kb][sp].z, s0); s1 = dot2ones(pf[kb][sp].w, s1); }
    return s0 + s1;
}
__device__ __forceinline__ void mla_qk(const LAS unsigned char* kbuf, const bf16x8 (&qf)[6], const f32x16& negm, f32x16 (&C)[2], int r, int hi) {
#pragma unroll
    for (int s = 0; s < 6; ++s)
#pragma unroll
        for (int kb = 0; kb < 2; ++kb) { const bf16x8 A = *(const LAS bf16x8*)(kbuf + (32 * kb + r) * MLA_KSTR + (16 * s + 8 * hi) * 2);
            C[kb] = __builtin_amdgcn_mfma_f32_32x32x16_bf16(A, qf[s], s == 0 ? negm : C[kb], 0, 0, 0); }
}
__device__ __forceinline__ void mla_pv(const LAS unsigned char* vbuf, const u32x4 (&pf)[2][2], f32x16 (&o)[2], int hi, int blk, int q, int pp) {
    const LAS unsigned char* pv0 = vbuf + (4 * hi + q) * MLA_VSTR + (16 * blk + 4 * pp) * 2;
#pragma unroll
    for (int k = 0; k < 4; ++k) {
        const LAS unsigned char* pk = pv0 + (16 * k) * MLA_VSTR;
        const bf16x8 v0 = cat4(tr_read(pk), tr_read(pk + 8 * MLA_VSTR)), v1 = cat4(tr_read(pk + 64), tr_read(pk + 64 + 8 * MLA_VSTR));
        const bf16x8 P = __builtin_bit_cast(bf16x8, pf[k >> 1][k & 1]);
        o[0] = __builtin_amdgcn_mfma_f32_32x32x16_bf16(v0, P, o[0], 0, 0, 0);
        o[1] = __builtin_amdgcn_mfma_f32_32x32x16_bf16(v1, P, o[1], 0, 0, 0);
    }
}
template <bool DOQK, bool DOPV>
__device__ __forceinline__ bf16x8 mla_frag(int i, const LAS unsigned char* pk0, const LAS unsigned char* pv0) {
    if (i < 8) { if (!DOPV) return bf16x8{}; const LAS unsigned char* p = pv0 + (16 * (i >> 1)) * MLA_VSTR + 64 * (i & 1); return cat4(tr_read(p), tr_read(p + 8 * MLA_VSTR)); }
    if (!DOQK) return bf16x8{};
    const int j = i - 8; return *(const LAS bf16x8*)(pk0 + 32 * (j & 1) * MLA_KSTR + 32 * (j >> 1));
}
struct MlaStage { u32x4 rk[2], rv[2]; u32x2 rr[2]; };
template <bool DOQK, bool DOPV, bool DOSM, bool DOSTG, bool DOPRE, bool HAVEPRE, int TP>
__device__ __forceinline__ void mla_step(int tp, int qw0, int qi, const LAS unsigned char* lk0, const LAS unsigned char* lv0, const bf16x8 (&qf)[6], f32x16& negm, f32x16 (&o)[2], MlaState& S,
                                         f32x16 (&C)[2], f32x16 (&Pp)[2], const u32x4 (&pfin)[2][2], u32x4 (&pfout)[2][2], bf16x8 (&vpre)[3], MlaStage& G,
                                         LAS unsigned char* lkw, LAS unsigned char* lkr, LAS unsigned char* lvw, const char* gk0, const char* gk1, const char* gr0, const char* gr1, const char* gv0, const char* gv1,
                                         unsigned gvo, unsigned gro, int hi) {
    if (DOSM) mla_mask(tp, qw0, qi, hi, Pp);
    const LAS unsigned char* const pk0 = lk0 + TP * MLA_KB;
    const LAS unsigned char* const pv0 = lv0 + ((TP + 2) & 3) * MLA_VB;
    const LAS unsigned char* const pn0 = lv0 + ((TP + 3) & 3) * MLA_VB;
    if (DOSTG) {
        *(LAS u32x4*)(lkw + ((TP + 2) & 3) * MLA_KB) = G.rk[0]; *(LAS u32x2*)(lkr + ((TP + 2) & 3) * MLA_KB) = G.rr[0]; *(LAS u32x4*)(lkw + ((TP + 3) & 3) * MLA_KB) = G.rk[1]; *(LAS u32x2*)(lkr + ((TP + 3) & 3) * MLA_KB) = G.rr[1];
        *(LAS u32x4*)(lvw + TP * MLA_VB) = G.rv[0]; *(LAS u32x4*)(lvw + ((TP + 1) & 3) * MLA_VB) = G.rv[1];
        unsigned vk = gvo, vr = gro; asm volatile("" : "+v"(vk), "+v"(vr));
        G.rk[0] = *(const u32x4*)(gk0 + vk); G.rr[0] = *(const u32x2*)(gr0 + vr); G.rk[1] = *(const u32x4*)(gk1 + vk); G.rr[1] = *(const u32x2*)(gr1 + vr);
        G.rv[0] = *(const u32x4*)(gv0 + vk); G.rv[1] = *(const u32x4*)(gv1 + vk);
    }
    constexpr int MO[23] = {0, 1, 2, 8, 3, 9, 4, 10, 5, 11, 6, 12, 7, 13, 14, 15, 16, 17, 18, 19, 20, 20, 20};
    bf16x8 fr[23];
    float s0 = 0.f, s1 = 0.f;
    unsigned pw[16];
    if (DOPV && HAVEPRE) { fr[0] = vpre[0]; fr[1] = vpre[1]; fr[2] = vpre[2]; }
    else { fr[0] = mla_frag<DOQK, DOPV>(MO[0], pk0, pv0); fr[1] = mla_frag<DOQK, DOPV>(MO[1], pk0, pv0); fr[2] = mla_frag<DOQK, DOPV>(MO[2], pk0, pv0); }
    __builtin_amdgcn_sched_barrier(0);
#pragma unroll
    for (int i = 0; i < 20; ++i) {
        if (i + 3 < 20) fr[i + 3] = mla_frag<DOQK, DOPV>(MO[i + 3], pk0, pv0);
        if (DOPRE && i >= 17) vpre[i - 17] = mla_frag<false, true>(i - 17, pn0, pn0);
        { const int mi = MO[i];
          if (mi < 8) { if (DOPV) o[mi & 1] = __builtin_amdgcn_mfma_f32_32x32x16_bf16(fr[i], __builtin_bit_cast(bf16x8, pfin[mi >> 2][(mi >> 1) & 1]), o[mi & 1], 0, 0, 0); }
          else if (DOQK) { const int j = mi - 8, s = j >> 1, kb = j & 1; C[kb] = __builtin_amdgcn_mfma_f32_32x32x16_bf16(fr[i], qf[s], s == 0 ? negm : C[kb], 0, 0, 0); } }
        if (DOSM) {
            if (i < 16) { const int kb = i >> 3, reg = 2 * (i & 7); Pp[kb][reg] = fexp2(Pp[kb][reg]); Pp[kb][reg + 1] = fexp2(Pp[kb][reg + 1]); }
            if (i >= 2 && i < 18) { const int e = i - 2, kb = e >> 3, reg = 2 * (e & 7); pw[e] = cvt_pk_bf16(Pp[kb][reg], Pp[kb][reg + 1]); }
            if (i >= 3 && i < 19) { const int e = i - 3; if (e & 1) s1 = dot2ones(pw[e], s1); else s0 = dot2ones(pw[e], s0); }
        }
        __builtin_amdgcn_sched_barrier(0);
    }
    if (DOSM) {
#pragma unroll
        for (int kb = 0; kb < 2; ++kb)
#pragma unroll
            for (int sp = 0; sp < 2; ++sp) { pfout[kb][sp].x = pw[8 * kb + 4 * sp]; pfout[kb][sp].y = pw[8 * kb + 4 * sp + 1]; pfout[kb][sp].z = pw[8 * kb + 4 * sp + 2]; pfout[kb][sp].w = pw[8 * kb + 4 * sp + 3]; }
        const float ts = s0 + s1; S.l += ts;
        if (__any(ts >= 2.0f)) {
            const float dl = fmaxf(flog2(mla_rowmax(Pp)) + MLA_HEAD, 0.f), f = fexp2(-dl);
            S.m += dl; S.l *= f;
#pragma unroll
            for (int reg = 0; reg < 16; ++reg) negm[reg] = -S.m;
            asm volatile("" : "+v"(negm));
            Pp[0] = Pp[0] * f; Pp[1] = Pp[1] * f; mla_pack(Pp, pfout);
            o[0] = o[0] * f; o[1] = o[1] * f;
            if (DOQK) {
#pragma unroll
                for (int kb = 0; kb < 2; ++kb)
#pragma unroll
                    for (int reg = 0; reg < 16; ++reg) C[kb][reg] -= dl; }
        }
    }
}
constexpr int MLA_VOFF4 = 4 * MLA_KB;
__device__ __forceinline__ void mla_unit(const Frame& F, int b, int h, int qb) {
    int tid_ = F.tid; asm volatile("" : "+v"(tid_));
    unsigned char* ws = F.ws; const int tid = tid_, lane = tid & 63, wid = F.wave;
    const bf16_t* Q = (const bf16_t*)(ws + WS_Q); const bf16_t* KV = (const bf16_t*)(ws + WS_KV); const bf16_t* KPE = (const bf16_t*)(ws + WS_KPE); bf16_t* MIX = (bf16_t*)*(float* const CAS*)(F.kp + 192);
    const int r = lane & 31, hi = lane >> 5, blk = (lane >> 4) & 1, q = (lane & 15) >> 2, pp = lane & 3;
    const size_t rowb = (size_t)b * SEQ; const int qw0 = qb * 256 + wid * 32, qi = qw0 + r;
    bf16x8 qf[6];
#pragma unroll
    for (int s = 0; s < 6; ++s) qf[s] = *(const bf16x8*)(Q + (rowb + qi) * 768 + h * 96 + 16 * s + 8 * hi);
    const int srow = tid >> 3, sch = tid & 7;
    const unsigned voK = (unsigned)(srow * 1024 + sch * 8) * 2u, voR = (unsigned)(srow * 32 + sch * 4) * 2u;
    const char* const bK = (const char*)(KV + rowb * 1024 + h * 64); const char* const bV = bK + 512 * 2; const char* const bR = (const char*)(KPE + rowb * 32);
    const int NT = 4 * (qb + 1);
    LAS unsigned char* const L = F.lds;
    const int kwo = srow * MLA_KSTR + sch * 16, kro = srow * MLA_KSTR + 128 + sch * 8, vwo = MLA_VOFF4 + srow * MLA_VSTR + sch * 16;
#define MLA_LDK(tile) (*(const u32x4*)(bK + (size_t)(tile) * (64 * 1024 * 2) + voK))
#define MLA_LDV(tile) (*(const u32x4*)(bV + (size_t)(tile) * (64 * 1024 * 2) + voK))
#define MLA_LDR(tile) (*(const u32x2*)(bR + (size_t)(tile) * (64 * 32 * 2) + voR))
#define MLA_BAR() do { asm volatile("s_waitcnt lgkmcnt(0)" ::: "memory"); __builtin_amdgcn_s_barrier(); asm volatile("" ::: "memory"); } while (0)
    MlaStage G;
    { const u32x4 k0 = MLA_LDK(0), k1 = MLA_LDK(1); const u32x2 r0 = MLA_LDR(0), r1 = MLA_LDR(1);
      G.rk[0] = MLA_LDK(2); G.rr[0] = MLA_LDR(2); G.rk[1] = MLA_LDK(3); G.rr[1] = MLA_LDR(3); G.rv[0] = MLA_LDV(0); G.rv[1] = MLA_LDV(1);
      *(LAS u32x4*)(L + kwo) = k0; *(LAS u32x2*)(L + kro) = r0; *(LAS u32x4*)(L + MLA_KB + kwo) = k1; *(LAS u32x2*)(L + MLA_KB + kro) = r1; }
    MLA_BAR();
    int ko = r * MLA_KSTR + 16 * hi, vo = (4 * hi + q) * MLA_VSTR + (16 * blk + 4 * pp) * 2; asm volatile("" : "+v"(ko), "+v"(vo));
    MlaState S; S.m = 0.f; S.l = 0.f;
    f32x16 negm = {}, o[2] = {{}, {}}, CA[2], CB[2];
    u32x4 pfE[2][2], pfO[2][2];
    bf16x8 vpre[3];
    const LAS unsigned char* lk0; const LAS unsigned char* lv0; LAS unsigned char* lkw; LAS unsigned char* lkr; LAS unsigned char* lvw;
    { unsigned a0 = (unsigned)(size_t)L + (unsigned)ko, a1 = (unsigned)(size_t)L + (unsigned)kwo, a2 = (unsigned)(size_t)L + (unsigned)kro, a3 = (unsigned)(size_t)L + (unsigned)(MLA_VOFF4 + vo), a4 = (unsigned)(size_t)L + (unsigned)vwo;
      asm volatile("" : "+v"(a0), "+v"(a1), "+v"(a2), "+v"(a3), "+v"(a4));
      lk0 = (const LAS unsigned char*)(size_t)a0; lkw = (LAS unsigned char*)(size_t)a1; lkr = (LAS unsigned char*)(size_t)a2; lv0 = (const LAS unsigned char*)(size_t)a3; lvw = (LAS unsigned char*)(size_t)a4; }
    { *(LAS u32x4*)(L + 2 * MLA_KB + kwo) = G.rk[0]; *(LAS u32x2*)(L + 2 * MLA_KB + kro) = G.rr[0]; *(LAS u32x4*)(L + 3 * MLA_KB + kwo) = G.rk[1]; *(LAS u32x2*)(L + 3 * MLA_KB + kro) = G.rr[1];
      *(LAS u32x4*)(L + vwo) = G.rv[0]; *(LAS u32x4*)(L + MLA_VB + vwo) = G.rv[1];
      const int t4 = 4 < NT ? 4 : NT - 1, t5 = 5 < NT ? 5 : NT - 1;
      G.rk[0] = MLA_LDK(t4); G.rr[0] = MLA_LDR(t4); G.rk[1] = MLA_LDK(t5); G.rr[1] = MLA_LDR(t5); G.rv[0] = MLA_LDV(2); G.rv[1] = MLA_LDV(3); }
    mla_qk(L, qf, negm, CA, r, hi);
    mla_qk(L + MLA_KB, qf, negm, CB, r, hi);
    { mla_mask(0, qw0, qi, hi, CA); const float mx = mla_rowmax(CA) + MLA_HEAD; S.m = mx;
#pragma unroll
      for (int kb = 0; kb < 2; ++kb)
#pragma unroll
          for (int reg = 0; reg < 16; ++reg) { CA[kb][reg] = fexp2(CA[kb][reg] - mx); CB[kb][reg] -= mx; }
#pragma unroll
      for (int reg = 0; reg < 16; ++reg) negm[reg] = -mx;
      asm volatile("" : "+v"(negm));
      asm volatile("s_nop 1" : "+v"(CA[0]), "+v"(CA[1]));
      mla_pack(CA, pfO); S.l = mla_rowsum(pfO); }
    MLA_BAR();
#define MLA_DSTEP(t_, TP_) do { const int t__ = (t_); const int tk0 = t__ + 4 < NT ? t__ + 4 : NT - 1, tk1 = t__ + 5 < NT ? t__ + 5 : NT - 1, tv0 = t__ + 2 < NT ? t__ + 2 : NT - 1, tv1 = t__ + 3 < NT ? t__ + 3 : NT - 1; \
        mla_step<true, true, true, true, true, false, TP_>(t__ - 1, qw0, qi, lk0, lv0, qf, negm, o, S, CA, CB, pfO, pfE, vpre, G, lkw, lkr, lvw, \
            bK + (size_t)tk0 * (64 * 1024 * 2), bK + (size_t)tk1 * (64 * 1024 * 2), bR + (size_t)tk0 * (64 * 32 * 2), bR + (size_t)tk1 * (64 * 32 * 2), bV + (size_t)tv0 * (64 * 1024 * 2), bV + (size_t)tv1 * (64 * 1024 * 2), voK, voR, hi); \
        mla_step<true, true, true, false, false, true, TP_ + 1>(t__, qw0, qi, lk0, lv0, qf, negm, o, S, CB, CA, pfE, pfO, vpre, G, lkw, lkr, lvw, bK, bK, bR, bR, bV, bV, 0u, 0u, hi); \
        MLA_BAR(); } while (0)
    MLA_DSTEP(2, 2);
#pragma unroll 1
    for (int t = 4; t < NT; t += 4) { MLA_DSTEP(t, 0); MLA_DSTEP(t + 2, 2); }
    mla_step<false, true, true, false, true, false, 0>(NT - 1, qw0, qi, lk0, lv0, qf, negm, o, S, CA, CB, pfO, pfE, vpre, G, lkw, lkr, lvw, bK, bK, bR, bR, bV, bV, 0u, 0u, hi);
    mla_step<false, true, false, false, false, true, 1>(NT, qw0, qi, lk0, lv0, qf, negm, o, S, CB, CA, pfE, pfO, vpre, G, lkw, lkr, lvw, bK, bK, bR, bR, bV, bV, 0u, 0u, hi);
#undef MLA_DSTEP
#undef MLA_LDK
#undef MLA_LDV
#undef MLA_LDR
#undef MLA_BAR
    float l = S.l; l += __shfl_xor(l, 32); const float inv = frcp(l);
#pragma unroll
    for (int dvb = 0; dvb < 2; ++dvb)
#pragma unroll
        for (int g = 0; g < 4; ++g) { const int v = 32 * dvb + 8 * g + 4 * hi; u32x2 w; w.x = cvt_pk_bf16(o[dvb][4 * g] * inv, o[dvb][4 * g + 1] * inv); w.y = cvt_pk_bf16(o[dvb][4 * g + 2] * inv, o[dvb][4 * g + 3] * inv);
            *(u32x2*)(MIX + (rowb + qi) * 1024 + h * 64 + v) = w; }
    __syncthreads();
}

constexpr int SW_STR = 144, SW_WAVE_BYTES = 2 * 32 * SW_STR;
constexpr int SWA_ROWS = 384, SWA_VOFF = SWA_ROWS * SW_STR, SWA_UNITS = 8 * 3 * 64;
__device__ __forceinline__ void swa_unit_decode(int u, int& b, int& head, int& br, int& dsh, int& rho, int& ib) {
    const int bh = u / 192, rem = u - bh * 192; b = bh >> 2; head = bh & 3; br = rem >> 6; const int j64 = rem & 63;
    dsh = 2 * br; rho = j64 >> (6 - dsh); ib = 256 * (j64 & ((64 >> dsh) - 1));
}
__device__ __forceinline__ void swa_phase(const Frame& F) {
    int tid_ = F.tid; asm volatile("" : "+v"(tid_));
    unsigned char* ws = F.ws; const int tid = tid_, lane = tid & 63, wid = F.wave;
    const bf16_t* PROJ = (const bf16_t*)(ws + WS_PROJ); bf16_t* SWO = (bf16_t*)(ws + WS_SWO); float* SWL = (float*)(ws + WS_SWL);
    const int r = lane & 31, hi = lane >> 5, blk = (lane >> 4) & 1, q = (lane & 15) >> 2, pp = lane & 3;
    LAS unsigned char* Lk = F.lds; LAS unsigned char* Lv = F.lds + SWA_VOFF;
    const int srow = tid >> 3, sch = tid & 7;
    const int vcu = (F.G % 8 == 0) ? (F.bx % 8) * (F.G / 8) + F.bx / 8 : F.bx;
    u32x4 rk[6], rv[6];
#define SWA_ISSUE(u_) do { int b_, head_, br_, dsh_, rho_, ib_; swa_unit_decode((u_), b_, head_, br_, dsh_, rho_, ib_); \
        _Pragma("unroll") for (int i = 0; i < 6; ++i) { int ik = ib_ - 128 + srow + 64 * i; ik = ik < 0 ? 0 : ik; \
            const bf16_t* src = PROJ + ((size_t)b_ * SEQ + rho_ + ((size_t)ik << dsh_)) * D_INP + head_ * 64 + sch * 8; rk[i] = *(const u32x4*)(src + C_SWK); rv[i] = *(const u32x4*)(src + C_SWV); } } while (0)
    f32x16 biasLo, biasHi;
    { const int d = r - 4 * hi;
#pragma unroll
      for (int reg = 0; reg < 16; ++reg) { const int c = (reg & 3) + 8 * (reg >> 2); biasLo[reg] = c < d ? -1e30f : 0.f; biasHi[reg] = c > d ? -1e30f : 0.f; } }
    const bool xl = F.G == 256; const int ustep = xl ? 32 : F.G, uend = xl ? (F.bx % 8) * 192 + 192 : SWA_UNITS;
    int u = xl ? (F.bx % 8) * 192 + F.bx / 8 : vcu;
    if (u < uend) SWA_ISSUE(u);
#pragma unroll 1
    for (; u < uend; u += ustep) {
        int b, head, br, dsh, rho, ib; swa_unit_decode(u, b, head, br, dsh, rho, ib);
        const size_t rowb = (size_t)b * SEQ;
        const int iq = ib + 32 * wid + r; const size_t tokq = rowb + rho + ((size_t)iq << dsh);
        bf16x8 qf[4];
#pragma unroll
        for (int s4 = 0; s4 < 4; ++s4) qf[s4] = *(const bf16x8*)(PROJ + tokq * D_INP + C_SWQ + head * 64 + 16 * s4 + 8 * hi);
#pragma unroll
        for (int i = 0; i < 6; ++i) { *(LAS u32x4*)(Lk + (srow + 64 * i) * SW_STR + sch * 16) = rk[i]; *(LAS u32x4*)(Lv + (srow + 64 * i) * SW_STR + sch * 16) = rv[i]; }
        __syncthreads();
        if (u + ustep < uend) SWA_ISSUE(u + ustep);
        f32x16 st[5];
#pragma unroll
        for (int tau = 0; tau < 5; ++tau) {
            const int lrow = 32 * wid + 32 * tau;
            f32x16 acc = tau == 0 ? biasLo : (tau == 4 ? biasHi : f32x16{});
#pragma unroll
            for (int s4 = 0; s4 < 4; ++s4) { const bf16x8 A = *(const LAS bf16x8*)(Lk + (lrow + r) * SW_STR + (16 * s4 + 8 * hi) * 2); acc = __builtin_amdgcn_mfma_f32_32x32x16_bf16(A, qf[s4], acc, 0, 0, 0); }
            st[tau] = acc;
        }
        if (ib < 128) {
#pragma unroll
            for (int tau = 0; tau < 5; ++tau) { const int e = ib - 128 + 32 * wid + 32 * tau + 4 * hi;
#pragma unroll
                for (int reg = 0; reg < 16; ++reg) { const int c = (reg & 3) + 8 * (reg >> 2); st[tau][reg] = (c + e < 0) ? -1e30f : st[tau][reg]; } }
        }
        float mxa = max3f(st[0][0], st[0][1], st[0][2]), mxb = max3f(st[0][3], st[0][4], st[0][5]);
#pragma unroll
        for (int i = 6; i < 80; i += 4) { mxa = max3f(mxa, st[i >> 4][i & 15], st[(i + 1) >> 4][(i + 1) & 15]); if (i + 2 < 80) mxb = max3f(mxb, st[(i + 2) >> 4][(i + 2) & 15], st[(i + 3) >> 4][(i + 3) & 15]); }
        const float m = swapmax32(fmaxf(mxa, mxb));
        float s0 = 0.f, s1 = 0.f; f32x16 o[2] = {{}, {}};
#pragma unroll
        for (int tau = 0; tau < 5; ++tau) {
            const LAS unsigned char* vt = Lv + (32 * wid + 32 * tau) * SW_STR;
#pragma unroll
            for (int sp = 0; sp < 2; ++sp) {
                u32x4 pw;
#pragma unroll
                for (int j = 0; j < 8; ++j) st[tau][8 * sp + j] = fexp2(st[tau][8 * sp + j] - m);
                asm volatile("s_nop 0" : "+v"(st[tau]));
                pw.x = cvt_pk_bf16(st[tau][8 * sp + 0], st[tau][8 * sp + 1]); pw.y = cvt_pk_bf16(st[tau][8 * sp + 2], st[tau][8 * sp + 3]);
                pw.z = cvt_pk_bf16(st[tau][8 * sp + 4], st[tau][8 * sp + 5]); pw.w = cvt_pk_bf16(st[tau][8 * sp + 6], st[tau][8 * sp + 7]);
                s0 = dot2ones(pw.x, s0); s1 = dot2ones(pw.y, s1); s0 = dot2ones(pw.z, s0); s1 = dot2ones(pw.w, s1);
                const bf16x8 P = __builtin_bit_cast(bf16x8, pw);
#pragma unroll
                for (int dvb = 0; dvb < 2; ++dvb) { const LAS unsigned char* pa = vt + (16 * sp + 4 * hi + q) * SW_STR + (32 * dvb + 16 * blk + 4 * pp) * 2;
                    const bf16x8 A = cat4(tr_read(pa), tr_read(pa + 8 * SW_STR));
                    o[dvb] = __builtin_amdgcn_mfma_f32_32x32x16_bf16(A, P, o[dvb], 0, 0, 0); }
            }
        }
        const float l = s0 + s1;
        const float lt = l + __shfl_xor(l, 32); const float inv = frcp(lt);
#pragma unroll
        for (int dvb = 0; dvb < 2; ++dvb)
#pragma unroll
            for (int g = 0; g < 4; ++g) { const int v = 32 * dvb + 8 * g + 4 * hi; u32x2 w; w.x = cvt_pk_bf16(o[dvb][4 * g] * inv, o[dvb][4 * g + 1] * inv); w.y = cvt_pk_bf16(o[dvb][4 * g + 2] * inv, o[dvb][4 * g + 3] * inv);
                *(u32x2*)(SWO + ((size_t)br * T + tokq) * 256 + head * 64 + v) = w; }
        if (hi == 0) SWL[((size_t)br * T + tokq) * 4 + head] = m + flog2(lt);
        __syncthreads();
    }
#undef SWA_ISSUE
}
__device__ __forceinline__ void swa_merge_phase(const Frame& F, int skip) {
    unsigned char* ws = F.ws; const bf16_t* SWO = (const bf16_t*)(ws + WS_SWO); const float* SWL = (const float*)(ws + WS_SWL); bf16_t* MIX = (bf16_t*)*(float* const CAS*)(F.kp + 192);
    if (F.bx < skip) return;
    for (int it = (F.bx - skip) * 512 + F.tid; it < T * 32; it += (F.G - skip) * 512) {
        const int row = it >> 3, c8 = it & 7; const size_t tok = (size_t)(row >> 2); const int head = row & 3;
        const u32x4 a0 = *(const u32x4*)(SWO + ((size_t)0 * T + tok) * 256 + head * 64 + c8 * 8), a1 = *(const u32x4*)(SWO + ((size_t)1 * T + tok) * 256 + head * 64 + c8 * 8), a2 = *(const u32x4*)(SWO + ((size_t)2 * T + tok) * 256 + head * 64 + c8 * 8);
        const float l0 = SWL[((size_t)0 * T + tok) * 4 + head], l1 = SWL[((size_t)1 * T + tok) * 4 + head], l2 = SWL[((size_t)2 * T + tok) * 4 + head];
        const float M = fmaxf(l0, fmaxf(l1, l2)); float w0 = fexp2(l0 - M), w1 = fexp2(l1 - M), w2 = fexp2(l2 - M); const float iw = 1.0f / (w0 + w1 + w2); w0 *= iw; w1 *= iw; w2 *= iw;
        u32x4 ow;
        ow.x = cvt_pk_bf16(w0 * bflo(a0.x) + w1 * bflo(a1.x) + w2 * bflo(a2.x), w0 * bfhi(a0.x) + w1 * bfhi(a1.x) + w2 * bfhi(a2.x));
        ow.y = cvt_pk_bf16(w0 * bflo(a0.y) + w1 * bflo(a1.y) + w2 * bflo(a2.y), w0 * bfhi(a0.y) + w1 * bfhi(a1.y) + w2 * bfhi(a2.y));
        ow.z = cvt_pk_bf16(w0 * bflo(a0.z) + w1 * bflo(a1.z) + w2 * bflo(a2.z), w0 * bfhi(a0.z) + w1 * bfhi(a1.z) + w2 * bfhi(a2.z));
        ow.w = cvt_pk_bf16(w0 * bflo(a0.w) + w1 * bflo(a1.w) + w2 * bflo(a2.w), w0 * bfhi(a0.w) + w1 * bfhi(a1.w) + w2 * bfhi(a2.w));
        *(u32x4*)(MIX + tok * 1024 + 768 + head * 64 + c8 * 8) = ow;
    }
}

#ifndef SITE_MASK
#define SITE_MASK 0xffffffffu
#endif
#ifndef REP_MASK
#define REP_MASK 0u
#endif
#ifndef REP_SWA
#define REP_SWA 1
#endif
#ifndef REP_ML1
#define REP_ML1 1
#endif
#ifndef REP_G2
#define REP_G2 1
#endif
#ifndef REP_ML3
#define REP_ML3 1
#endif
#ifndef REP_MLA
#define REP_MLA 1
#endif
#ifndef MLA_VAR
#define MLA_VAR 0
#endif
#define PHASE_BEGIN(site) if (((SITE_MASK >> (site)) & 1u) && ph >= lo && ph < hi) { Frame F = make_frame(ldsb, wave0); unsigned char* ws = F.ws; LAS unsigned char* xch = F.lds + XCH_OFF; \
        float* OUT = *(float* const CAS*)(F.kp + 192); bf16_t* XB = (bf16_t*)(ws + WS_H); bf16_t* MIX = (bf16_t*)OUT; float* XS = (float*)(ws + WS_XS); bf16_t* PROJ = (bf16_t*)(ws + WS_PROJ); bf16_t* Yb = (bf16_t*)(ws + WS_Y); (void)OUT; (void)XB; (void)MIX; (void)XS; (void)PROJ; (void)Yb; (void)xch; \
        _Pragma("unroll 1") for (int rep_ = 0; rep_ < (((REP_MASK >> (site)) & 1u) ? 2 : 1); ++rep_) {
#define PHASE_END   } if (ph + 1 < hi) { XcdBarrier bar; bar.bar = (unsigned*)(F.ws + WS_CTL) + 1024; bar.x = xb_xcc_id(); bar.st = (volatile LAS unsigned*)(ldsb + MISC_OFF) + 8; bar.wave0 = wave0; xcd_barrier(bar); } } ++ph;

#define BUILD_XATTN_WEIGHTS(l_) do { unsigned char* wb_ = ws + (((l_) & 1) ? WDELTA : 0); \
        { pg8::Gemm g{(const bf16_t*)(ws + WS_MEMK) + (size_t)(l_) * 512 * 1024, (const bf16_t*)(ws + WS_WXQR), 1024, 1024, 256}; pg8::Order<6> S; S.init(8, 4, F.G, F.bx, 1024, 1024); \
          pg8::EpiStore E{(bf16_t*)(wb_ + WS_WQK), 1024, nullptr}; pg8::gemm_phase(F.lds, xch, g, S, E, F.wave); } \
        { pg8::Gemm g{(const bf16_t*)(ws + WS_WXOT), (const bf16_t*)(ws + WS_MEMV) + (size_t)(l_) * 512 * 1024, 1024, 1024, 256}; pg8::Order<7> S; S.init(8, 4, F.G, F.G >= 64 ? (F.bx + F.G - 32) % F.G : F.bx, 1024, 1024); \
          pg8::EpiStore E{(bf16_t*)(wb_ + WS_WVO), 1024, nullptr}; pg8::gemm_phase(F.lds, xch, g, S, E, F.wave); } } while (0)
template <int l> __device__ __forceinline__ void run_layer(LAS unsigned char* const ldsb, const int wave0, int& ph, const int lo, const int hi) {
        PHASE_BEGIN(2)
            pg8::Gemm g{XB, (const bf16_t*)(ws + WS_WIN + ((l & 1) ? WDELTA : 0)), 1024, 1024, 1024}; pg8::Order<0> S; S.init(T / 256, D_INP / 256, F.G, F.bx, 1024, 1024);
            pg8::EpiProj E{PROJ, XS, (bf16_t*)(ws + WS_KPE), (float*)(ws + WS_GATE), (float*)(ws + WS_SSQ), (const float*)(ws + WS_TMC), (const float*)(ws + WS_TMS), (const float*)(ws + WS_TSC), (const float*)(ws + WS_TSS),
                           F.in(9) + l * 4, F.in(10) + l * 4, 0.125f * LOG2E};
            pg8::gemm_phase(F.lds, xch, g, S, E, F.wave);
            if (2 * F.bx >= F.G) {
                Frame Fc = make_frame(ldsb, wave0); Fc.gw = (Fc.bx - Fc.G / 2) * NWAVES + Fc.wave; Fc.NGW = (Fc.G - Fc.G / 2) * NWAVES; convert_ffn_weights(Fc, l); }
        PHASE_END
        PHASE_BEGIN(4)
            _Pragma("unroll 1") for (int rq = 0; rq < REP_G2; ++rq)
            if ((SITE_MASK >> 17) & 1u) { pg8::Gemm g{PROJ + C_CQ, (const bf16_t*)(ws + WS_WUQ + ((l & 1) ? WDELTA : 0)), D_INP, 256, 256}; pg8::Order<0> S; S.init(T / 256, 3, F.G, F.bx, D_INP, 256);
              pg8::EpiQ E{(bf16_t*)(ws + WS_Q), (const float*)(ws + WS_TMC), (const float*)(ws + WS_TMS), 0.10206207261596577f * LOG2E, (const float*)(ws + WS_SSQ)}; pg8::gemm_phase(F.lds, xch, g, S, E, F.wave); }
            _Pragma("unroll 1") for (int rq = 0; rq < REP_G2; ++rq)
            if ((SITE_MASK >> 18) & 1u) { pg8::Gemm g{PROJ + C_CKV, (const bf16_t*)(ws + WS_WUKV + ((l & 1) ? WDELTA : 0)), D_INP, 128, 128}; pg8::Order<0> S; S.init(T / 256, 4, F.G, F.bx, D_INP, 128);
              pg8::EpiStoreKV E{(bf16_t*)(ws + WS_KV), 1024, (const float*)(ws + WS_SSQ)}; pg8::gemm_phase(F.lds, xch, g, S, E, F.wave); }
            if ((SITE_MASK >> 19) & 1u) { _Pragma("unroll 1") for (int rep = 0; rep < REP_ML1; ++rep) ml1_phase(F, F.in(7) + (size_t)l * 4 * 512, F.in(8) + (size_t)l * 512); }
        PHASE_END
        PHASE_BEGIN(5)
            ml2_phase(F);
            if (F.bx >= ML2_WGS) {
            Frame Fc = F; Fc.gw = (F.bx - ML2_WGS) * NWAVES + F.wave; Fc.NGW = (F.G - ML2_WGS) * NWAVES;
            if (l + 1 < DEPTH) convert_attn_weights(Fc, l + 1);
            }
        PHASE_END
        PHASE_BEGIN(6)
            { const int vcu = (F.G % 8 == 0) ? (F.bx % 8) * (F.G / 8) + F.bx / 8 : F.bx;
_Pragma("unroll 1")
              for (int rep = 0; rep < REP_MLA; ++rep)
              for (int p2 = 2 * vcu; p2 < 1024; p2 += ((p2 & 1) ? 2 * F.G - 1 : 1)) { const int p = p2 >> 1, bh = p >> 5, j = p & 31; mla_unit(F, bh >> 3, bh & 7, (p2 & 1) ? 63 - j : j); }
            }
            { const Frame F2 = make_frame(ldsb, wave0);
_Pragma("unroll 1")
              for (int rep = 0; rep < REP_SWA; ++rep) swa_phase(F2); }
            { const Frame F3 = make_frame(ldsb, wave0);
_Pragma("unroll 1")
              for (int rep = 0; rep < REP_ML3; ++rep) ml3_phase(F3); }
        PHASE_END
        PHASE_BEGIN(3)
            swa_merge_phase(F, (l + 1 < DEPTH && F.G >= 128) ? 64 : 0);
            if (l + 1 < DEPTH) BUILD_XATTN_WEIGHTS(l + 1);
        PHASE_END
        PHASE_BEGIN(7)
            pg8::Gemm g{MIX, (const bf16_t*)(ws + WS_WOUT + ((l & 1) ? WDELTA : 0)), 1024, 1024, 1024}; pg8::Order<0> S; S.init(T / 256, 4, F.G, F.bx, 1024, 1024);

#ifdef PROBE_RESID
            { pg8::EpiResidual<false> Ed{(bf16_t*)(ws + 392 * MiB), nullptr, F.in(18) + l * DM, (float*)(ws + 457 * MiB), (float*)(ws + 456 * MiB), (unsigned*)(ws + WS_CTL + WS_CNT + 8192), 4u * (3 * l + 1), XB}; pg8::gemm_phase(F.lds, xch, g, S, Ed, F.wave); }
#endif
            pg8::EpiResidual<false> E{XB, nullptr, F.in(18) + l * DM, (float*)(ws + WS_SL), XS, (unsigned*)(ws + WS_CTL + WS_CNT), 4u * (3 * l + 1)}; pg8::gemm_phase(F.lds, xch, g, S, E, F.wave);
        PHASE_END
        PHASE_BEGIN(9)
            pg8::Gemm g{XB, (const bf16_t*)(ws + WS_WQK + ((l & 1) ? WDELTA : 0)), 1024, 1024, 1024}; pg8::Order<5> S; S.init(T / 256, 4, F.G, F.bx, 1024, 1024);
            pg8::EpiSoftmax E{(bf16_t*)(ws + WS_P), 0.0625f * LOG2E, XS}; pg8::gemm_phase(F.lds, xch, g, S, E, F.wave);
        PHASE_END
        PHASE_BEGIN(12)
            pg8::Gemm g{(const bf16_t*)(ws + WS_P), (const bf16_t*)(ws + WS_WVO + ((l & 1) ? WDELTA : 0)), 1024, 1024, 1024}; pg8::Order<5> S; S.init(T / 256, 4, F.G, F.bx, 1024, 1024);

#ifdef PROBE_RESID
            { pg8::EpiResidual<false> Ed{(bf16_t*)(ws + 392 * MiB), nullptr, F.in(21) + l * DM, (float*)(ws + 457 * MiB), (float*)(ws + 456 * MiB), (unsigned*)(ws + WS_CTL + WS_CNT + 8192), 4u * (3 * l + 2), XB}; pg8::gemm_phase(F.lds, xch, g, S, Ed, F.wave); }
#endif
            pg8::EpiResidual<false> E{XB, nullptr, F.in(21) + l * DM, (float*)(ws + WS_SL), XS, (unsigned*)(ws + WS_CTL + WS_CNT), 4u * (3 * l + 2)}; pg8::gemm_phase(F.lds, xch, g, S, E, F.wave);
        PHASE_END
#ifdef PROBE_G8PHASE
        PHASE_BEGIN(20)
            pg8::Gemm g{XB, (const bf16_t*)(ws + WS_WGU), 1024, 1024, 1024}; pg8::Order<0> S; S.init(T / 256, 22, F.G, F.bx, 1024, 1024);
            pg8::EpiSwiGLU E{(bf16_t*)(ws + 136 * MiB), XS}; pg8::gemm_phase(F.lds, xch, g, S, E, F.wave);
        PHASE_END
#endif
        PHASE_BEGIN(14)
            pg8::Gemm g{XB, (const bf16_t*)(ws + WS_WGU), 1024, 1024, 1024}; pg8::Order<0> S; S.init(T / 256, 22, F.G, F.bx, 1024, 1024);
            pg8::EpiSwiGLU E{(bf16_t*)(ws + WS_ACT), XS}; pg8::gemm_phase(F.lds, xch, g, S, E, F.wave);
        PHASE_END
        PHASE_BEGIN(15)
            pg8::Gemm g{(const bf16_t*)(ws + WS_ACT), (const bf16_t*)(ws + WS_WDN), D_FF, D_FF, D_FF}; pg8::Order<0> S; S.init(T / 256, 4, F.G, F.bx, D_FF, D_FF);
            if (l + 1 < DEPTH) {
#ifdef PROBE_RESID
            { pg8::EpiResidual<false> Ed{(bf16_t*)(ws + 392 * MiB), nullptr, F.in(23) + l * DM, (float*)(ws + 457 * MiB), (float*)(ws + 456 * MiB), (unsigned*)(ws + WS_CTL + WS_CNT + 8192), 4u * (3 * l + 3), XB}; pg8::gemm_phase(F.lds, xch, g, S, Ed, F.wave); }
#endif
            pg8::EpiResidual<false> E{XB, nullptr, F.in(23) + l * DM, (float*)(ws + WS_SL), XS, (unsigned*)(ws + WS_CTL + WS_CNT), 4u * (3 * l + 3)}; pg8::gemm_phase(F.lds, xch, g, S, E, F.wave); }
            else {
#ifdef PROBE_RESID
            { pg8::EpiResidual<false> Ed{(bf16_t*)(ws + 392 * MiB), nullptr, F.in(23) + l * DM, (float*)(ws + 457 * MiB), (float*)(ws + 456 * MiB), (unsigned*)(ws + WS_CTL + WS_CNT + 8192), 4u * (3 * l + 3), XB}; pg8::gemm_phase(F.lds, xch, g, S, Ed, F.wave); }
#endif
            pg8::EpiResidual<true> E{XB, OUT, F.in(23) + l * DM, (float*)(ws + WS_SL), XS, (unsigned*)(ws + WS_CTL + WS_CNT), 4u * (3 * l + 3)}; pg8::gemm_phase(F.lds, xch, g, S, E, F.wave); }
        PHASE_END
}

__global__ void __launch_bounds__(NWAVES * 64, 2) trunk_fwd(Args args) {
    extern __shared__ __attribute__((aligned(16))) unsigned char lds_raw[];
    LAS unsigned char* const ldsb = (LAS unsigned char*)lds_raw;
    { volatile LAS unsigned* MISC = (volatile LAS unsigned*)(ldsb + MISC_OFF);
      if (threadIdx.x < 32) MISC[threadIdx.x] = 0u;
      __syncthreads();
      (void)xcd_barrier_post((unsigned*)(args.ws + WS_CTL) + 1024, MISC + 8); }
    const int wave0 = __builtin_amdgcn_readfirstlane(threadIdx.x >> 6);
    const int lo = args.ph_lo, hi = args.ph_hi;
    int ph = 0;
    PHASE_BEGIN(0)
        convert_attn_weights(F, 0);
        prologue_misc(F);
        resid_init_phase(F, F.in(0), XB, XS);
    PHASE_END
    PHASE_BEGIN(1)
        { pg8::Gemm g{(const bf16_t*)(ws + WS_MEMN), (const bf16_t*)(ws + WS_WXKVT), 1024, 1024, 1024}; pg8::Order<3> S; S.init(8, 4, F.G, F.bx, 1024, 1024);
          pg8::EpiStore E{(bf16_t*)(ws + WS_MEMK), 1024, nullptr}; pg8::gemm_phase(F.lds, xch, g, S, E, F.wave); }
        { pg8::Gemm g{(const bf16_t*)(ws + WS_MEMN), (const bf16_t*)(ws + WS_WXKVT), 1024, 1024, 1024}; pg8::Order<4> S; S.init(8, 4, F.G, F.G >= 64 ? (F.bx + F.G - 32) % F.G : F.bx, 1024, 1024);
          pg8::EpiStore E{(bf16_t*)(ws + WS_MEMV), 1024, nullptr}; pg8::gemm_phase(F.lds, xch, g, S, E, F.wave); }
    PHASE_END
    PHASE_BEGIN(17)
        BUILD_XATTN_WEIGHTS(0);
    PHASE_END

    run_layer<0>(ldsb, wave0, ph, lo, hi); run_layer<1>(ldsb, wave0, ph, lo, hi); run_layer<2>(ldsb, wave0, ph, lo, hi); run_layer<3>(ldsb, wave0, ph, lo, hi);
}
#undef PHASE_BEGIN
#undef PHASE_END

#ifndef PH_STOP
#define PH_STOP 1000
#endif
extern "C" void kernel_launch(void* const* d_in, const int* in_sizes, int n_in, void* d_out, int out_size, void* d_ws, size_t ws_size, hipStream_t stream) {
    static int grid = 0;
    if (grid == 0) {
        if (n_in != 24 || out_size != T * DM || ws_size < WS_END) { fprintf(stderr, "kernel_launch: unexpected sizes n_in %d out %d ws %zu\n", n_in, out_size, ws_size); grid = -1; return; }
        int dev = 0, cus = 0, per_cu = 0;
        if (hipGetDevice(&dev) != hipSuccess || hipDeviceGetAttribute(&cus, hipDeviceAttributeMultiprocessorCount, dev) != hipSuccess) { grid = -1; return; }
        if (hipFuncSetAttribute((const void*)trunk_fwd, hipFuncAttributeMaxDynamicSharedMemorySize, LDS_BYTES) != hipSuccess) { fprintf(stderr, "kernel_launch: hipFuncSetAttribute failed\n"); grid = -1; return; }
        if (hipOccupancyMaxActiveBlocksPerMultiprocessor(&per_cu, (const void*)trunk_fwd, NWAVES * 64, LDS_BYTES) != hipSuccess || per_cu < 1) { fprintf(stderr, "kernel_launch: occupancy query says %d\n", per_cu); }
        (void)hipGetLastError();
        grid = cus;
    }
    if (grid < 0) return;
    hipMemsetAsync((char*)d_ws + WS_CTL, 0, CTL_ZERO_BYTES, stream);
    Args a{};
    for (int i = 0; i < 24; ++i) a.in[i] = (const float*)d_in[i];
    a.out = (float*)d_out; a.ws = (unsigned char*)d_ws; a.ph_lo = 0; a.ph_hi = PH_STOP;
    hipLaunchKernelGGL(trunk_fwd, dim3(grid), dim3(NWAVES * 64), LDS_BYTES, stream, a);
}
```

```cpp
#include <hip/hip_runtime.h>
#include <cstdio>
#include <cstdint>

#define LAS __attribute__((address_space(3)))
#define GAS __attribute__((address_space(1)))
typedef unsigned short bf16_t;
typedef short bf16x8 __attribute__((ext_vector_type(8)));
typedef short s16x4 __attribute__((ext_vector_type(4)));
typedef float f32x2 __attribute__((ext_vector_type(2)));
typedef float f32x4 __attribute__((ext_vector_type(4)));
typedef float f32x16 __attribute__((ext_vector_type(16)));
typedef unsigned u32x2 __attribute__((ext_vector_type(2)));
typedef unsigned u32x4 __attribute__((ext_vector_type(4)));
typedef GAS unsigned gu32;

constexpr int DM = 1024, NB = 2, SEQ = 16384, DEPTH = 4, T = NB * SEQ, NMEM = 256;
constexpr int D_IN = 2216, D_INP = 2304, D_FF = 2816;
constexpr float EPS = 1e-6f;
constexpr float LOG2E = 1.4426950408889634f;
constexpr int C_CQ = 0, C_CKV = 256, C_KR = 384, C_GATE = 416, C_MLQ = 512, C_MLK = 768, C_MLV = 1024, C_MLO = 1280, C_SWQ = 1536, C_SWK = 1792, C_SWV = 2048;
__host__ __device__ __forceinline__ int win_src_col(int n) {
    if (n < 384) return n;
    if (n < 416) { const int c = n - 384; return 384 + 16 * ((c >> 2) & 1) + 4 * (c >> 3) + (c & 3); }
    if (n < 424) return 1440 + (n - 416);
    if (n < 512) return -1;
    if (n < 1536) return 416 + (n - 512);
    if (n < 2048) { const int m = n - 1536, t = m >> 8, hh = (m >> 6) & 3, c = m & 63; const int dim = c < 16 ? 8 * ((c >> 2) & 1) + 4 * (c >> 3) + (c & 3) : c; return 1448 + t * 256 + hh * 64 + dim; }
    return 1960 + (n - 2048);
}

constexpr size_t MiB = 1u << 20;
constexpr size_t WS_CTL = 0, CTL_ZERO_BYTES = 64 * 1024;
constexpr size_t WS_TMC = 1 * MiB, WS_TMS = 2 * MiB, WS_TSC = 3 * MiB, WS_TSS = 3 * MiB + 512 * 1024;
constexpr size_t WS_WIN = 4 * MiB;
constexpr size_t WS_WUQ = WS_WIN + (size_t)D_INP * 1024 * 2;
constexpr size_t WS_WUKV = WS_WUQ + 768 * 256 * 2;
constexpr size_t WS_WOUT = WS_WUKV + 1024 * 128 * 2;
constexpr size_t WS_WQK = WS_WOUT + 2 * MiB;
constexpr size_t WS_WVO = WS_WQK + 4 * MiB;
static_assert(WS_WVO + 4 * MiB <= 20 * MiB, "attention-side weights");
constexpr size_t WS_WGU = 20 * MiB;
constexpr size_t WS_WDN = WS_WGU + 11 * MiB;
static_assert(WS_WDN + (size_t)1024 * 2816 * 2 <= 40 * MiB, "ffn weights");
constexpr size_t WS_MEMK = 490 * MiB;
constexpr size_t WS_MEMV = 494 * MiB;
constexpr size_t WS_WXQR = 498 * MiB;
constexpr size_t WS_WXOT = 500 * MiB;
constexpr size_t WS_KPE = 40 * MiB;
constexpr size_t WS_GATE = 42 * MiB;
constexpr size_t WS_MLB = 43 * MiB;
constexpr size_t WS_MLM = 43 * MiB + 16 * 1024;
constexpr size_t WS_RSTD = 43 * MiB + 64 * 1024;
constexpr size_t WS_MLU = 44 * MiB;
constexpr size_t WS_MLC = 61 * MiB;
constexpr size_t WS_MLN = 69 * MiB;
constexpr size_t WS_SWL = 70 * MiB;
constexpr size_t WS_H = 72 * MiB;
constexpr size_t WS_BIG = 136 * MiB;
constexpr size_t WS_PROJ = WS_BIG;
constexpr size_t WS_Q = 280 * MiB;
constexpr size_t WS_KV = 328 * MiB;
constexpr size_t WS_MLQK = 392 * MiB;
constexpr size_t WS_SWO = 424 * MiB;
constexpr size_t WS_Y = WS_BIG;
constexpr size_t WS_P = 264 * MiB;
constexpr size_t WS_ACT = 200 * MiB;
constexpr size_t WS_WXKVT = WS_BIG;
constexpr size_t WS_MEMN = WS_BIG + 16 * MiB;
constexpr size_t WS_SSQ = 472 * MiB;
constexpr size_t WS_SL = 473 * MiB;
constexpr size_t WS_XS = 473 * MiB + 512 * 1024;
constexpr size_t WS_CNT = 32 * 1024;
constexpr size_t WS_W2ND = 474 * MiB;
constexpr size_t WDELTA = WS_W2ND - WS_WIN;
constexpr size_t WS_END = 502 * MiB;
static_assert(WS_ACT + (size_t)T * D_FF * 2 <= WS_END, "act");

constexpr int RING_BYTES = 131072;
constexpr int XCH_OFF = RING_BYTES;
constexpr int MISC_OFF = XCH_OFF + 8192;
constexpr int LDS_BYTES = 147456;
constexpr int NWAVES = 8;

__device__ __forceinline__ unsigned cvt_pk_bf16(float lo, float hi) { unsigned r; asm volatile("v_cvt_pk_bf16_f32 %0, %1, %2" : "=v"(r) : "v"(lo), "v"(hi)); return r; }
__device__ __forceinline__ float bf2f(unsigned short b) { return __uint_as_float(((unsigned)b) << 16); }
__device__ __forceinline__ float bflo(unsigned w) { return __uint_as_float(w << 16); }
__device__ __forceinline__ float bfhi(unsigned w) { return __uint_as_float(w & 0xffff0000u); }
__device__ __forceinline__ bf16_t f2bf(float f) { return (bf16_t)(cvt_pk_bf16(f, 0.f) & 0xffffu); }
__device__ __forceinline__ void unpack8(const u32x4 w, float (&v)[8]) { v[0] = bflo(w.x); v[1] = bfhi(w.x); v[2] = bflo(w.y); v[3] = bfhi(w.y); v[4] = bflo(w.z); v[5] = bfhi(w.z); v[6] = bflo(w.w); v[7] = bfhi(w.w); }
__device__ __forceinline__ u32x4 pack8(const float (&v)[8]) { u32x4 w; w.x = cvt_pk_bf16(v[0], v[1]); w.y = cvt_pk_bf16(v[2], v[3]); w.z = cvt_pk_bf16(v[4], v[5]); w.w = cvt_pk_bf16(v[6], v[7]); return w; }
__device__ __forceinline__ float wave_sum(float v) {
#pragma unroll
    for (int o = 1; o < 64; o <<= 1) v += __shfl_xor(v, o);
    return v;
}
__device__ __forceinline__ float fexp2(float x) { return __builtin_amdgcn_exp2f(x); }
__device__ __forceinline__ float flog2(float x) { return __builtin_amdgcn_logf(x); }
__device__ __forceinline__ float frcp(float x) { return __builtin_amdgcn_rcpf(x); }
__device__ __forceinline__ int crow(int reg, int hi) { return (reg & 3) + 8 * (reg >> 2) + 4 * hi; }
__device__ __forceinline__ int hw_lane() { int l; asm volatile("v_mbcnt_lo_u32_b32 %0, -1, 0\n\tv_mbcnt_hi_u32_b32 %0, -1, %0" : "=v"(l)); return l; }
#define LDS_WAIT() asm volatile("s_waitcnt lgkmcnt(0)" ::: "memory")
#define VM_WAIT() asm volatile("s_waitcnt vmcnt(0)" ::: "memory")
__device__ __forceinline__ s16x4 tr_read(const LAS unsigned char* p) {
    typedef short v4i16_t __attribute__((ext_vector_type(4)));
    return __builtin_bit_cast(s16x4, __builtin_amdgcn_ds_read_tr16_b64_v4i16((LAS v4i16_t*)p));
}
__device__ __forceinline__ bf16x8 cat4(s16x4 a, s16x4 b) { return (bf16x8){a[0], a[1], a[2], a[3], b[0], b[1], b[2], b[3]}; }

#define XB_TMO      128
#define XB_XCNT(j)  (256  + 64 * (j))
#define XB_XSUB(j)  (1280 + 64 * (j))
#define XB_XGEN(j)  (2304 + 64 * (j))
#define XB_TOP      3328
#define XB_TOPGEN   3392
#define XCD_BAR_WORDS 3456
#define XB_SPIN_CAP (1u << 22)
__device__ __forceinline__ unsigned xb_ld(unsigned* p)              { return __hip_atomic_load(p, __ATOMIC_RELAXED, __HIP_MEMORY_SCOPE_AGENT); }
__device__ __forceinline__ unsigned xb_add(unsigned* p, unsigned v) { return __hip_atomic_fetch_add(p, v, __ATOMIC_RELAXED, __HIP_MEMORY_SCOPE_AGENT); }
__device__ __forceinline__ unsigned xb_xcc_id() { return (unsigned)__builtin_amdgcn_s_getreg((3 << 11) | 20) & 0xFu; }
#define XB_SPIN(cond, bar) do { unsigned _sp = 0; while (cond) { __builtin_amdgcn_s_sleep(1); \
    if ((++_sp & 255u) == 0u) { if (xb_ld(&(bar)[XB_TMO])) break; if (_sp > XB_SPIN_CAP) { atomicAdd(&(bar)[XB_TMO], 1u); break; } } } } while (0)
struct XcdBarrier { unsigned* bar; unsigned x; volatile LAS unsigned* st; int wave0; };
__device__ __forceinline__ XcdBarrier xcd_barrier_post(unsigned* bar, volatile LAS unsigned* st) {
    XcdBarrier b; b.bar = bar; b.x = xb_xcc_id(); b.st = st;
    if (threadIdx.x == 0) (void)xb_add(&bar[XB_XCNT(b.x)], 1u);
    return b;
}
__device__ __forceinline__ void xcd_barrier_complete(unsigned* bar, unsigned x, unsigned& nloc, unsigned& nx) {
    const unsigned G = gridDim.x * gridDim.y * gridDim.z;
    unsigned sum, cnt, mine, sp = 0u;
    for (;;) {
        sum = 0u; cnt = 0u; mine = 0u;
#pragma unroll
        for (unsigned j = 0; j < 16; ++j) { const unsigned c = xb_ld(&bar[XB_XCNT(j)]); sum += c; cnt += (c > 0u) ? 1u : 0u; mine = (j == x) ? c : mine; }
        if (sum == G) break;
        __builtin_amdgcn_s_sleep(1);
        if ((++sp & 255u) == 0u) { if (xb_ld(&bar[XB_TMO])) break; if (sp > XB_SPIN_CAP) { atomicAdd(&bar[XB_TMO], 1u); break; } }
    }
    nloc = mine > 0u ? mine : 1u; nx = cnt > 0u ? cnt : 1u;
}
__device__ __forceinline__ void xcd_barrier(const XcdBarrier& b) {
    asm volatile("s_waitcnt vmcnt(0)" ::: "memory");
    __syncthreads();
    if (b.wave0 == 0 && hw_lane() == 0) {
        unsigned* bar = b.bar;
        __builtin_amdgcn_s_waitcnt(0);
        unsigned nloc = b.st[0], nx = b.st[1];
        if (nloc == 0u) { xcd_barrier_complete(bar, b.x, nloc, nx); b.st[0] = nloc; b.st[1] = nx; }
        const unsigned old = xb_add(&bar[XB_XSUB(b.x)], 1u);
        const unsigned gen = old / nloc;
        if (old + 1u == (gen + 1u) * nloc) {
            __builtin_amdgcn_fence(__ATOMIC_RELEASE, "agent");
            asm volatile("s_waitcnt vmcnt(0)" ::: "memory");
            const unsigned og = xb_add(&bar[XB_TOP], 1u);
            const unsigned tg = og / nx;
            if (og + 1u == (tg + 1u) * nx) xb_add(&bar[XB_TOPGEN], 1u);
            else XB_SPIN(xb_ld(&bar[XB_TOPGEN]) == tg, bar);
            __builtin_amdgcn_fence(__ATOMIC_ACQUIRE, "agent");
            xb_add(&bar[XB_XGEN(b.x)], 1u);
            asm volatile("s_waitcnt vmcnt(0)" ::: "memory");
        } else {
            XB_SPIN(xb_ld(&bar[XB_XGEN(b.x)]) == gen, bar);
            __builtin_amdgcn_fence(__ATOMIC_ACQUIRE, "agent");
            asm volatile("s_waitcnt vmcnt(0)" ::: "memory");
        }
    }
    __syncthreads();
}

namespace pg8 {
constexpr int BM = 256, BK = 64, HALF = 128, HTB = HALF * BK * 2, STAGE_BYTES = 8 * HTB, NXCD = 8, WGM = 8;
__host__ __device__ __forceinline__ int lds_byte(int r, int c) { const int st = (r >> 4) * 2 + (c >> 5), rr = r & 15, cc = c & 31, ob = rr * 64 + cc * 2; return st * 1024 + (ob ^ (((ob >> 9) & 1) << 5)); }
__host__ __device__ __forceinline__ void stage_rc(int b, int& R, int& C) { const int st = b / 1024, sb = b % 1024, swz = sb ^ (((sb >> 9) & 1) << 5); R = (st >> 1) * 16 + swz / 64; C = (st & 1) * 32 + (swz % 64) / 2; }
__host__ __device__ __forceinline__ int perm32(int rho) { const int n = rho >> 4, i = rho & 15; return 8 * (i >> 2) + 4 * n + (i & 3); }

struct Unit { int pm, pn; size_t aoff, boff; };
struct Gemm { const bf16_t* A; const bf16_t* Bt; int lda, ldb, K; };

__device__ __forceinline__ int xcd_remap(int wgid, int nwg) { const int q = nwg / NXCD, r = nwg % NXCD, xcd = wgid % NXCD, off = wgid / NXCD; return (xcd < r ? xcd * (q + 1) : r * (q + 1) + (xcd - r) * q) + off; }

template <int MODE> struct Order {
    int nM, nN, nwg, G, c, lda, ldb;
    __device__ __forceinline__ void init(int nM_, int nN_, int G_, int c_, int lda_, int ldb_) { nM = nM_; nN = nN_; nwg = nM_ * nN_; G = G_; c = c_; lda = lda_; ldb = ldb_; }
    __device__ __forceinline__ bool next(int i, Unit& u) const {
        const long L = (long)i * G + c; if (L >= nwg) return false;
        const int wgid = xcd_remap((int)L, nwg);
        if (MODE == 0) {
            const int nig = WGM * nN, gid = wgid / nig, fm = gid * WGM, gsz = (nM - fm) < WGM ? (nM - fm) : WGM;
            u.pm = fm + ((wgid % nig) % gsz); u.pn = (wgid % nig) / gsz;
            u.aoff = (size_t)u.pm * BM * lda * 2; u.boff = (size_t)u.pn * BM * ldb * 2;
        } else if (MODE == 1 || MODE == 2) {
            const int bh = wgid >> 6, rt = wgid & 63, b = bh >> 2, h = bh & 3;
            u.pm = b * 64 + rt; u.pn = h;
            u.aoff = ((size_t)u.pm * BM * lda + h * 256) * 2;
            u.boff = (MODE == 1) ? ((size_t)(b * 256) * 1024 + h * 256) * 2 : ((size_t)(b * 1024 + h * 256) * 256) * 2;
        } else if (MODE == 3) {
            u.pm = wgid >> 2; u.pn = wgid & 3;
            u.aoff = (size_t)u.pm * BM * 1024 * 2; u.boff = ((size_t)(u.pm >> 1) * 2048 * 1024 + (size_t)u.pn * BM * 1024) * 2;
        } else if (MODE == 4) {
            u.pm = wgid >> 2; u.pn = wgid & 3;
            u.aoff = (size_t)u.pm * BM * 1024 * 2; u.boff = ((size_t)(u.pm >> 1) * 2048 * 1024 + (size_t)(1024 + u.pn * BM) * 1024) * 2;
        } else if (MODE == 5) {
            const int nig = WGM * nN, gid = wgid / nig, fm = gid * WGM, gsz = (nM - fm) < WGM ? (nM - fm) : WGM;
            u.pm = fm + ((wgid % nig) % gsz); u.pn = (wgid % nig) / gsz;
            u.aoff = (size_t)u.pm * BM * lda * 2; u.boff = ((size_t)(u.pm >> 6) * 1024 + (size_t)u.pn * BM) * ldb * 2;
        } else if (MODE == 6) {
            const int bh = wgid >> 2, ct = wgid & 3, b = bh >> 2, h = bh & 3;
            u.pm = bh; u.pn = ct;
            u.aoff = ((size_t)(b * 256) * 1024 + h * 256) * 2; u.boff = ((size_t)(ct * 256) * 1024 + h * 256) * 2;
        } else {
            const int b = wgid >> 4, h = (wgid >> 2) & 3, rt = wgid & 3;
            u.pm = b * 4 + rt; u.pn = h;
            u.aoff = ((size_t)(rt * 256) * 1024 + h * 256) * 2; u.boff = ((size_t)(b * 256) * 1024 + h * 256) * 2;
        }
        return true;
    }
};

__device__ __forceinline__ float rstd4(const float* p) { const f32x4 v = *(const f32x4*)p; return __builtin_amdgcn_rsqf(((v[0] + v[1]) + (v[2] + v[3])) * (1.0f / DM) + EPS); }
template <int RS> struct EpiStoreT {
    static constexpr bool PERM = true;
    bf16_t* O; int ldc; const float* rs;
    __device__ __forceinline__ void operator()(f32x4 (&acc)[2][2][4][2], const Unit& u, int wr, int wc, int fr, int fq, LAS unsigned char* xch) const {
        const int row0 = u.pm * BM + wr * 64 + fr, col0 = u.pn * BM + wc * 32 + 8 * fq;
#pragma unroll
        for (int ai = 0; ai < 2; ++ai)
#pragma unroll
            for (int m = 0; m < 4; ++m) { bf16_t* rowp = O + (size_t)(row0 + ai * HALF + m * 16) * ldc + col0; float sc = 1.0f;
                if (RS == 0) asm volatile("" : "+v"(sc));
                if (RS == 1) sc = rstd4(rs + (size_t)(row0 + ai * HALF + m * 16) * 4);
                if (RS == 2) { const f32x4 p4 = *(const f32x4*)(rs + (size_t)(row0 + ai * HALF + m * 16) * 8 + 4); sc = __builtin_amdgcn_rsqf(((p4[0] + p4[1]) + (p4[2] + p4[3])) * (1.0f / 128.f) + EPS); }
#pragma unroll
                for (int bj = 0; bj < 2; ++bj) { const f32x4 v0 = acc[ai][bj][m][0] * sc, v1 = acc[ai][bj][m][1] * sc;
                    u32x4 w; w.x = cvt_pk_bf16(v0[0], v0[1]); w.y = cvt_pk_bf16(v0[2], v0[3]); w.z = cvt_pk_bf16(v1[0], v1[1]); w.w = cvt_pk_bf16(v1[2], v1[3]);
                    *(u32x4*)(rowp + bj * HALF) = w; } }
    }
};
typedef EpiStoreT<0> EpiStore;
typedef EpiStoreT<1> EpiStoreRS;
typedef EpiStoreT<2> EpiStoreKV;
struct EpiQ {
    static constexpr bool PERM = false;
    bf16_t* O; const float* tcos; const float* tsin; float scale; const float* ssq;
    __device__ __forceinline__ void operator()(f32x4 (&acc)[2][2][4][2], const Unit& u, int wr, int wc, int fr, int fq, LAS unsigned char* xch) const {
#pragma unroll
        for (int ai = 0; ai < 2; ++ai)
#pragma unroll
            for (int m = 0; m < 4; ++m) {
                const int row = u.pm * BM + ai * HALF + wr * 64 + m * 16 + fr, pos = row & (SEQ - 1);
                const f32x4 p4 = *(const f32x4*)(ssq + (size_t)row * 8); const float rsc = scale * __builtin_amdgcn_rsqf(((p4[0] + p4[1]) + (p4[2] + p4[3])) * (1.0f / 256.f) + EPS);
#pragma unroll
                for (int bj = 0; bj < 2; ++bj) {
                    const int g = 8 * u.pn + 4 * bj + wc;
                    f32x4 x1 = acc[ai][bj][m][0], x2 = acc[ai][bj][m][1];
                    if ((g % 3) == 2) {
                        const f32x4 c = *(const f32x4*)(tcos + pos * 16 + 4 * fq), s = *(const f32x4*)(tsin + pos * 16 + 4 * fq);
                        const f32x4 o1 = x1 * c - x2 * s, o2 = x2 * c + x1 * s; x1 = o1; x2 = o2;
                    }
                    x1 = x1 * rsc; x2 = x2 * rsc;
                    bf16_t* p = O + (size_t)row * 768 + g * 32 + 4 * fq;
                    u32x2 w1, w2; w1.x = cvt_pk_bf16(x1[0], x1[1]); w1.y = cvt_pk_bf16(x1[2], x1[3]); w2.x = cvt_pk_bf16(x2[0], x2[1]); w2.y = cvt_pk_bf16(x2[2], x2[3]);
                    *(u32x2*)p = w1; *(u32x2*)(p + 16) = w2;
                }
            }
    }
};
struct EpiSwiGLU {
    static constexpr bool PERM = true;
    bf16_t* O; const float* rs;
    __device__ __forceinline__ void operator()(f32x4 (&acc)[2][2][4][2], const Unit& u, int wr, int wc, int fr, int fq, LAS unsigned char* xch) const {
        const int row0 = u.pm * BM + wr * 64 + fr, col0 = u.pn * HALF + wc * 32 + 8 * fq;
#pragma unroll
        for (int ai = 0; ai < 2; ++ai)
#pragma unroll
            for (int m = 0; m < 4; ++m) {
                float a[8]; const float sc = rstd4(rs + (size_t)(row0 + ai * HALF + m * 16) * 4);
#pragma unroll
                for (int n = 0; n < 2; ++n)
#pragma unroll
                    for (int j = 0; j < 4; ++j) { const float g = acc[ai][0][m][n][j] * sc, up = acc[ai][1][m][n][j] * sc; a[n * 4 + j] = g * frcp(1.f + fexp2(-g * LOG2E)) * up; }
                u32x4 w; w.x = cvt_pk_bf16(a[0], a[1]); w.y = cvt_pk_bf16(a[2], a[3]); w.z = cvt_pk_bf16(a[4], a[5]); w.w = cvt_pk_bf16(a[6], a[7]);
                *(u32x4*)(O + (size_t)(row0 + ai * HALF + m * 16) * D_FF + col0) = w;
            }
    }
};
struct EpiProj {
    static constexpr bool PERM = true;
    bf16_t* O; const float* rs; bf16_t* KPE; float* GATE; float* SSQ; const float* tmc; const float* tms; const float* tsc; const float* tss; const float* bi; const float* bf; float qs;
    __device__ __forceinline__ void operator()(f32x4 (&acc)[2][2][4][2], const Unit& u, int wr, int wc, int fr, int fq, LAS unsigned char* xch) const {
        const int row0 = u.pm * BM + wr * 64 + fr, col0 = u.pn * BM + wc * 32 + 8 * fq, pn = u.pn;
#pragma unroll
        for (int ai = 0; ai < 2; ++ai)
#pragma unroll
            for (int m = 0; m < 4; ++m) {
                const int row = row0 + ai * HALF + m * 16, pos = row & (SEQ - 1); const float sc = rstd4(rs + (size_t)row * 4);
                bf16_t* rowp = O + (size_t)row * D_INP + col0;
                f32x4 v[2][2];
#pragma unroll
                for (int bj = 0; bj < 2; ++bj) { v[bj][0] = acc[ai][bj][m][0] * sc; v[bj][1] = acc[ai][bj][m][1] * sc; }
                if (pn <= 1) {
                    float ss = 0.f;
#pragma unroll
                    for (int bj = 0; bj < 2; ++bj) if (pn == 0 || bj == 0) {
#pragma unroll
                        for (int n = 0; n < 2; ++n) ss += (v[bj][n][0] * v[bj][n][0] + v[bj][n][1] * v[bj][n][1]) + (v[bj][n][2] * v[bj][n][2] + v[bj][n][3] * v[bj][n][3]); }
                    ss += __shfl_xor(ss, 16); ss += __shfl_xor(ss, 32);
                    if (fq == 0) SSQ[(size_t)row * 8 + 4 * pn + wc] = ss;
                }
                if (pn == 1) {
                    if (wc == 0) {
                        const f32x4 c = *(const f32x4*)(tmc + pos * 16 + 4 * fq), s = *(const f32x4*)(tms + pos * 16 + 4 * fq);
                        const f32x4 o1 = v[1][0] * c - v[1][1] * s, o2 = v[1][1] * c + v[1][0] * s;
                        u32x2 w1, w2; w1.x = cvt_pk_bf16(o1[0], o1[1]); w1.y = cvt_pk_bf16(o1[2], o1[3]); w2.x = cvt_pk_bf16(o2[0], o2[1]); w2.y = cvt_pk_bf16(o2[2], o2[3]);
                        *(u32x2*)(KPE + (size_t)row * 32 + 4 * fq) = w1; *(u32x2*)(KPE + (size_t)row * 32 + 16 + 4 * fq) = w2;
                    } else if (wc == 1 && fq == 0) {
                        f32x4 li, lf;
#pragma unroll
                        for (int j = 0; j < 4; ++j) { li[j] = v[1][0][j] + bi[j]; const float z = v[1][1][j] + bf[j]; lf[j] = fminf(z, 0.f) - log1pf(expf(-fabsf(z))); }
                        *(f32x4*)(GATE + (size_t)row * 8) = li; *(f32x4*)(GATE + (size_t)row * 8 + 4) = lf;
                    }
                }
                if (pn == 6 || pn == 7) {
                    if ((wc & 1) == 0 && fq < 2) {
                        const f32x4 c = *(const f32x4*)(tsc + pos * 8 + 4 * fq), s = *(const f32x4*)(tss + pos * 8 + 4 * fq);
#pragma unroll
                        for (int bj = 0; bj < 2; ++bj) { const f32x4 o1 = v[bj][0] * c - v[bj][1] * s, o2 = v[bj][1] * c + v[bj][0] * s; v[bj][0] = o1; v[bj][1] = o2; }
                    }
                    if (pn == 6) {
#pragma unroll
                        for (int bj = 0; bj < 2; ++bj) { v[bj][0] = v[bj][0] * qs; v[bj][1] = v[bj][1] * qs; } }
                }
#pragma unroll
                for (int bj = 0; bj < 2; ++bj) {
                    if (pn == 1 && bj == 1) continue;
                    u32x4 w; w.x = cvt_pk_bf16(v[bj][0][0], v[bj][0][1]); w.y = cvt_pk_bf16(v[bj][0][2], v[bj][0][3]); w.z = cvt_pk_bf16(v[bj][1][0], v[bj][1][1]); w.w = cvt_pk_bf16(v[bj][1][2], v[bj][1][3]);
                    *(u32x4*)(rowp + bj * HALF) = w; }
            }
    }
};
template <bool LAST> struct EpiResidual {
    static constexpr bool PERM = true;
    bf16_t* XB; float* OUT; const float* g; float* SL; float* XS; unsigned* cnt; unsigned target; const bf16_t* XBld = nullptr;
    __device__ __forceinline__ void operator()(f32x4 (&acc)[2][2][4][2], const Unit& u, int wr, int wc, int fr_, int fq_, LAS unsigned char* xch) const {
        LAS float* XP = (LAS float*)xch; LAS float* RS = (LAS float*)(xch + 4096);
        int fr = fr_, fq = fq_; asm volatile("" : "+v"(fr), "+v"(fq));
        const int t = (wr * 4 + wc) * 64 + fq * 16 + fr;
        const int col0 = u.pn * BM + wc * 32 + 8 * fq;
        u32x4 xw[2][4][2];
#pragma unroll
        for (int ai = 0; ai < 2; ++ai)
#pragma unroll
            for (int m = 0; m < 4; ++m)
#pragma unroll
                for (int bj = 0; bj < 2; ++bj) xw[ai][m][bj] = *(const u32x4*)((XBld ? XBld : XB) + ((size_t)u.pm * BM + ai * HALF + wr * 64 + m * 16 + fr) * DM + col0 + bj * HALF);
#pragma unroll
        for (int ai = 0; ai < 2; ++ai)
#pragma unroll
            for (int m = 0; m < 4; ++m) { float ss = 0.f;
#pragma unroll
                for (int bj = 0; bj < 2; ++bj)
#pragma unroll
                    for (int n = 0; n < 2; ++n) { const f32x4 v = acc[ai][bj][m][n]; ss += (v[0] * v[0] + v[1] * v[1]) + (v[2] * v[2] + v[3] * v[3]); }
                ss += __shfl_xor(ss, 16); ss += __shfl_xor(ss, 32);
                if (fq == 0) XP[(ai * HALF + wr * 64 + m * 16 + fr) * 4 + wc] = ss; }
        asm volatile("s_waitcnt lgkmcnt(0)" ::: "memory"); __builtin_amdgcn_s_barrier(); asm volatile("" ::: "memory");
        if (t < 256) { const f32x4 p4 = *(const LAS f32x4*)(XP + t * 4);
            __hip_atomic_store((unsigned*)(SL + ((size_t)u.pm * BM + t) * 4 + u.pn), __float_as_uint((p4[0] + p4[1]) + (p4[2] + p4[3])), __ATOMIC_RELAXED, __HIP_MEMORY_SCOPE_AGENT); }
        asm volatile("s_waitcnt vmcnt(0)" ::: "memory"); __builtin_amdgcn_s_barrier(); asm volatile("" ::: "memory");
        if (t == 0) { unsigned* c = cnt + u.pm * 16; (void)__hip_atomic_fetch_add(c, 1u, __ATOMIC_RELAXED, __HIP_MEMORY_SCOPE_AGENT);
            unsigned sp = 0; while (__hip_atomic_load(c, __ATOMIC_RELAXED, __HIP_MEMORY_SCOPE_AGENT) < target) { __builtin_amdgcn_s_sleep(1); if (++sp > (1u << 22)) break; } }
        asm volatile("s_waitcnt vmcnt(0) lgkmcnt(0)" ::: "memory"); __builtin_amdgcn_s_barrier(); asm volatile("" ::: "memory");
        if (t < 256) { const unsigned* s4 = (const unsigned*)(SL + ((size_t)u.pm * BM + t) * 4);
            const float a = __uint_as_float(__hip_atomic_load(s4 + 0, __ATOMIC_RELAXED, __HIP_MEMORY_SCOPE_AGENT)), b = __uint_as_float(__hip_atomic_load(s4 + 1, __ATOMIC_RELAXED, __HIP_MEMORY_SCOPE_AGENT)),
                        c = __uint_as_float(__hip_atomic_load(s4 + 2, __ATOMIC_RELAXED, __HIP_MEMORY_SCOPE_AGENT)), d = __uint_as_float(__hip_atomic_load(s4 + 3, __ATOMIC_RELAXED, __HIP_MEMORY_SCOPE_AGENT));
            RS[t] = __builtin_amdgcn_rsqf(((a + b) + (c + d)) * (1.0f / DM) + EPS); }
        asm volatile("s_waitcnt vmcnt(0) lgkmcnt(0)" ::: "memory"); __builtin_amdgcn_s_barrier(); asm volatile("" ::: "memory");
        f32x4 gv[2][2];
#pragma unroll
        for (int bj = 0; bj < 2; ++bj) { gv[bj][0] = *(const f32x4*)(g + col0 + bj * HALF); gv[bj][1] = *(const f32x4*)(g + col0 + bj * HALF + 4); }
#pragma unroll
        for (int ai = 0; ai < 2; ++ai)
#pragma unroll
            for (int m = 0; m < 4; ++m) {
                const int rl = ai * HALF + wr * 64 + m * 16 + fr; const size_t grow = (size_t)u.pm * BM + rl; const float rstd = RS[rl]; float ss2 = 0.f;
#pragma unroll
                for (int bj = 0; bj < 2; ++bj) {
                    float x[8]; unpack8(xw[ai][m][bj], x);
                    const f32x4 y0 = acc[ai][bj][m][0] * rstd * gv[bj][0], y1 = acc[ai][bj][m][1] * rstd * gv[bj][1];
                    x[0] += y0[0]; x[1] += y0[1]; x[2] += y0[2]; x[3] += y0[3]; x[4] += y1[0]; x[5] += y1[1]; x[6] += y1[2]; x[7] += y1[3];
                    if (LAST) { float* po = OUT + grow * DM + col0 + bj * HALF; *(f32x4*)po = (f32x4){x[0], x[1], x[2], x[3]}; *(f32x4*)(po + 4) = (f32x4){x[4], x[5], x[6], x[7]}; }
                    else { *(u32x4*)(XB + grow * DM + col0 + bj * HALF) = pack8(x);
#pragma unroll
                        for (int e = 0; e < 8; ++e) ss2 += x[e] * x[e]; }
                }
                if (!LAST) { ss2 += __shfl_xor(ss2, 16); ss2 += __shfl_xor(ss2, 32); if (fq == 0) XP[rl * 4 + wc] = ss2; }
            }
        if (!LAST) {
            asm volatile("s_waitcnt lgkmcnt(0)" ::: "memory"); __builtin_amdgcn_s_barrier(); asm volatile("" ::: "memory");
            if (t < 256) { const f32x4 p4 = *(const LAS f32x4*)(XP + t * 4); XS[((size_t)u.pm * BM + t) * 4 + u.pn] = (p4[0] + p4[1]) + (p4[2] + p4[3]); }
        }
        asm volatile("s_waitcnt lgkmcnt(0)" ::: "memory"); __builtin_amdgcn_s_barrier(); asm volatile("" ::: "memory");
    }
};
struct EpiSoftmax {
    static constexpr bool PERM = true;
    bf16_t* O; float scale2; const float* rs;
    __device__ __forceinline__ void operator()(f32x4 (&acc)[2][2][4][2], const Unit& u, int wr, int wc, int fr, int fq, LAS unsigned char* xch) const {
        LAS f32x2* X = (LAS f32x2*)xch;
#pragma unroll
        for (int ai = 0; ai < 2; ++ai)
#pragma unroll
            for (int m = 0; m < 4; ++m) {
                float mx = -3.0e38f; const float sc2 = scale2 * rstd4(rs + (size_t)(u.pm * BM + ai * HALF + wr * 64 + m * 16 + fr) * 4);
#pragma unroll
                for (int bj = 0; bj < 2; ++bj)
#pragma unroll
                    for (int n = 0; n < 2; ++n) { f32x4 v = acc[ai][bj][m][n] * sc2; acc[ai][bj][m][n] = v; mx = fmaxf(mx, fmaxf(fmaxf(v[0], v[1]), fmaxf(v[2], v[3]))); }
                mx = fmaxf(mx, __shfl_xor(mx, 16)); mx = fmaxf(mx, __shfl_xor(mx, 32));
                float sm = 0.f;
#pragma unroll
                for (int bj = 0; bj < 2; ++bj)
#pragma unroll
                    for (int n = 0; n < 2; ++n) { f32x4 v = acc[ai][bj][m][n]; v[0] = fexp2(v[0] - mx); v[1] = fexp2(v[1] - mx); v[2] = fexp2(v[2] - mx); v[3] = fexp2(v[3] - mx); acc[ai][bj][m][n] = v; sm += (v[0] + v[1]) + (v[2] + v[3]); }
                sm += __shfl_xor(sm, 16); sm += __shfl_xor(sm, 32);
                if (fq == 0) X[(ai * HALF + wr * 64 + m * 16 + fr) * 4 + wc] = (f32x2){mx, sm};
            }
        asm volatile("s_waitcnt lgkmcnt(0)" ::: "memory"); __builtin_amdgcn_s_barrier(); asm volatile("" ::: "memory");
        const int row0 = u.pm * BM + wr * 64 + fr, col0 = u.pn * BM + wc * 32 + 8 * fq;
#pragma unroll
        for (int ai = 0; ai < 2; ++ai)
#pragma unroll
            for (int m = 0; m < 4; ++m) {
                const int rl = ai * HALF + wr * 64 + m * 16 + fr;
                const f32x2 a = X[rl * 4 + 0], b = X[rl * 4 + 1], c = X[rl * 4 + 2], d = X[rl * 4 + 3];
                const float M = fmaxf(fmaxf(a.x, b.x), fmaxf(c.x, d.x));
                const float tot = a.y * fexp2(a.x - M) + b.y * fexp2(b.x - M) + c.y * fexp2(c.x - M) + d.y * fexp2(d.x - M);
                const f32x2 mine = X[rl * 4 + wc];
                const float f = fexp2(mine.x - M) * frcp(tot);
                bf16_t* rowp = O + (size_t)(row0 + ai * HALF + m * 16) * 1024 + col0;
#pragma unroll
                for (int bj = 0; bj < 2; ++bj) { const f32x4 v0 = acc[ai][bj][m][0] * f, v1 = acc[ai][bj][m][1] * f;
                    u32x4 w; w.x = cvt_pk_bf16(v0[0], v0[1]); w.y = cvt_pk_bf16(v0[2], v0[3]); w.z = cvt_pk_bf16(v1[0], v1[1]); w.w = cvt_pk_bf16(v1[2], v1[3]);
                    *(u32x4*)(rowp + bj * HALF) = w; }
            }
        asm volatile("s_waitcnt lgkmcnt(0)" ::: "memory"); __builtin_amdgcn_s_barrier(); asm volatile("" ::: "memory");
    }
};

template <class Epi, class Sched>
__device__ __forceinline__ void gemm_phase(LAS unsigned char* lds, LAS unsigned char* xch, const Gemm g, const Sched& S, const Epi& E, int wave0) {
    const int ln_ = hw_lane();
    int wid_ = wave0; asm volatile("" : "+s"(wid_));
    const int wid = wid_, lane = ln_, tid = wid * 64 + lane, wr = wid >> 2, wc = wid & 3, fr = lane & 15, fq = lane >> 4;
    int K_ = g.K; asm volatile("" : "+s"(K_));
    const int K = K_, nt = K / BK;
    unsigned voffA[2], voffB[2];
#pragma unroll
    for (int i = 0; i < 2; ++i) { int R, C; stage_rc(tid * 16 + i * 8192, R, C); const int Rb = Epi::PERM ? ((R & ~31) + perm32(R & 31)) : R;
        voffA[i] = (unsigned)(R * g.lda + C) * 2u; voffB[i] = (unsigned)(Rb * g.ldb + C) * 2u; }
    const size_t kstep = (size_t)(BK * 2);
    const size_t hsA = (size_t)HALF * g.lda * 2, hsB = (size_t)HALF * g.ldb * 2;
    const unsigned ldsw = (unsigned)wid * 1024u;
    const int aoff = lds_byte(wr * 64 + fr, fq * 8), boff = lds_byte(wc * 32 + fr, fq * 8);
#define PG8_SA(b, h) (((b) * 2 + (h)) * HTB)
#define PG8_SB(b, h) ((4 + (b) * 2 + (h)) * HTB)
#define PG8_STAGE(bufoff, gbase, voff) do { _Pragma("unroll") for (int _i = 0; _i < 2; ++_i) \
        __builtin_amdgcn_global_load_lds((const unsigned*)((const char*)(gbase) + (voff)[_i]), (LAS unsigned*)(lds + (bufoff) + ldsw + _i * 8192), 16, 0, 0); } while (0)
#define PG8_LDA(dst, b, h) do { _Pragma("unroll") for (int m = 0; m < 4; ++m) _Pragma("unroll") for (int k = 0; k < 2; ++k) dst[m][k] = *(const LAS bf16x8*)(lds + PG8_SA(b, h) + aoff + m * 2048 + k * 1024); } while (0)
#define PG8_LDB(dst, b, h) do { _Pragma("unroll") for (int n = 0; n < 2; ++n) _Pragma("unroll") for (int k = 0; k < 2; ++k) dst[n][k] = *(const LAS bf16x8*)(lds + PG8_SB(b, h) + boff + n * 2048 + k * 1024); } while (0)
#define PG8_MMA(ai, bj, At, Bt) do { __builtin_amdgcn_s_setprio(1); _Pragma("unroll") for (int m = 0; m < 4; ++m) _Pragma("unroll") for (int n = 0; n < 2; ++n) _Pragma("unroll") for (int k = 0; k < 2; ++k) \
        acc[ai][bj][m][n] = __builtin_amdgcn_mfma_f32_16x16x32_bf16(Bt[n][k], At[m][k], acc[ai][bj][m][n], 0, 0, 0); __builtin_amdgcn_s_setprio(0); } while (0)
#define PG8_WAIT_V(n) asm volatile("s_waitcnt vmcnt(" #n ")" ::: "memory")
#define PG8_WAIT_L(n) asm volatile("s_waitcnt lgkmcnt(" #n ")" ::: "memory")
#define PG8_BAR __builtin_amdgcn_s_barrier()
#define PG8_SCHED __builtin_amdgcn_sched_barrier(0)
    Unit cur, nxt; int ui = 0;
    if (!S.next(0, cur)) return;
    f32x4 acc[2][2][4][2];
#pragma unroll
    for (int a = 0; a < 2; ++a)
#pragma unroll
        for (int b = 0; b < 2; ++b)
#pragma unroll
            for (int m = 0; m < 4; ++m)
#pragma unroll
                for (int n = 0; n < 2; ++n) acc[a][b][m][n] = (f32x4){0.f, 0.f, 0.f, 0.f};
    bf16x8 At[4][2], B0[2][2], B1[2][2];
    const char* cA = (const char*)g.A + cur.aoff; const char* cB = (const char*)g.Bt + cur.boff;
    PG8_STAGE(PG8_SB(0, 0), cB, voffB); PG8_STAGE(PG8_SB(0, 1), cB + hsB, voffB); PG8_STAGE(PG8_SA(0, 0), cA, voffA); PG8_STAGE(PG8_SA(0, 1), cA + hsA, voffA);
    if (wr == 1) PG8_BAR;
    PG8_WAIT_V(2); PG8_BAR;
    PG8_STAGE(PG8_SB(1, 0), cB + kstep, voffB); PG8_STAGE(PG8_SA(1, 0), cA + kstep, voffA); PG8_STAGE(PG8_SB(1, 1), cB + hsB + kstep, voffB);
    PG8_WAIT_V(6); PG8_BAR;
    for (;;) {
        const bool has_next = S.next(ui + 1, nxt);
        const char* nA = has_next ? (const char*)g.A + nxt.aoff : cA; const char* nB = has_next ? (const char*)g.Bt + nxt.boff : cB;
#pragma unroll 1
        for (int t = 0; t < nt; t += 2) {
            const bool last = (t == nt - 2);
            const char* a1 = cA + (size_t)(t + 1) * kstep;
            const char* a2 = last ? nA : cA + (size_t)(t + 2) * kstep; const char* b2 = last ? nB : cB + (size_t)(t + 2) * kstep;
            const char* a3 = a2 + kstep; const char* b3 = b2 + kstep;
            PG8_LDB(B0, 0, 0); PG8_LDB(B1, 0, 1); PG8_SCHED; PG8_LDA(At, 0, 0); PG8_STAGE(PG8_SA(1, 1), a1 + hsA, voffA);
            PG8_WAIT_V(8); PG8_WAIT_L(0); PG8_BAR; PG8_MMA(0, 0, At, B0); PG8_MMA(0, 1, At, B1); PG8_BAR; PG8_SCHED;
            PG8_LDA(At, 0, 1); PG8_STAGE(PG8_SB(0, 0), b2, voffB); PG8_STAGE(PG8_SB(0, 1), b2 + hsB, voffB); PG8_STAGE(PG8_SA(0, 0), a2, voffA);
            PG8_WAIT_V(8); PG8_WAIT_L(0); PG8_BAR; PG8_MMA(1, 0, At, B0); PG8_MMA(1, 1, At, B1); PG8_BAR; PG8_SCHED;
            PG8_LDB(B0, 1, 0); PG8_LDB(B1, 1, 1); PG8_SCHED; PG8_LDA(At, 1, 0); PG8_STAGE(PG8_SA(0, 1), a2 + hsA, voffA);
            PG8_WAIT_V(8); PG8_WAIT_L(0); PG8_BAR; PG8_MMA(0, 0, At, B0); PG8_MMA(0, 1, At, B1); PG8_BAR; PG8_SCHED;
            PG8_LDA(At, 1, 1); PG8_STAGE(PG8_SB(1, 0), b3, voffB); PG8_STAGE(PG8_SB(1, 1), b3 + hsB, voffB); PG8_STAGE(PG8_SA(1, 0), a3, voffA);
            PG8_WAIT_V(8); PG8_WAIT_L(0); PG8_BAR; PG8_MMA(1, 0, At, B0); PG8_MMA(1, 1, At, B1); PG8_BAR; PG8_SCHED;
        }
        if (wr == 0) PG8_BAR;
        E(acc, cur, wr, wc, fr, fq, xch);
        if (!has_next) break;
#pragma unroll
        for (int a = 0; a < 2; ++a)
#pragma unroll
            for (int b = 0; b < 2; ++b)
#pragma unroll
                for (int m = 0; m < 4; ++m)
#pragma unroll
                    for (int n = 0; n < 2; ++n) acc[a][b][m][n] = (f32x4){0.f, 0.f, 0.f, 0.f};
        cur = nxt; cA = nA; cB = nB; ++ui;
        if (wr == 1) PG8_BAR;
    }
    PG8_WAIT_V(0);
    PG8_BAR;
#undef PG8_SA
#undef PG8_SB
#undef PG8_STAGE
#undef PG8_LDA
#undef PG8_LDB
#undef PG8_MMA
#undef PG8_WAIT_V
#undef PG8_WAIT_L
#undef PG8_BAR
#undef PG8_SCHED
}
}

struct Args { const float* in[24]; float* out; unsigned char* ws; int ph_lo, ph_hi; };
#define CAS __attribute__((address_space(4)))
struct Frame {
    const CAS unsigned char* kp;
    LAS unsigned char* lds;
    int tid, lane, wave, G, bx, gw, NGW;
    unsigned char* ws;
    __device__ __forceinline__ const float* in(int k) const { return *(const float* const CAS*)(kp + 8 * k); }
};
__device__ __forceinline__ Frame make_frame(LAS unsigned char* lds, int wave0) {
    Frame F;
    const CAS unsigned char* kp = (const CAS unsigned char*)__builtin_amdgcn_kernarg_segment_ptr(); asm volatile("" : "+s"(kp));
    F.kp = kp; F.lds = lds;
    const int ln = hw_lane();
    int wv = wave0; asm volatile("" : "+s"(wv));
    F.lane = ln; F.wave = wv; F.tid = wv * 64 + ln;
    int bx = blockIdx.x, G = gridDim.x; asm volatile("" : "+s"(bx), "+s"(G));
    F.bx = bx; F.G = G; F.gw = bx * NWAVES + F.wave; F.NGW = G * NWAVES;
    F.ws = *(unsigned char* const CAS*)(kp + 200);
    return F;
}

template <bool WINMAP = false>
__device__ __forceinline__ void transpose_item(const float* W, int ldw, int K, int k0, int sc0, int nvalid, bf16_t* Wt, int dr0, LAS float* scr, int lane, const float* kgain = nullptr) {
    if (WINMAP) {
        const int jj = lane & 31; const int scol = win_src_col(dr0 + jj);
#pragma unroll 8
        for (int i = 0; i < 32; ++i) { const int kk = 2 * i + (lane >> 5), j = lane & 31; float w = (scol >= 0) ? W[(size_t)(k0 + kk) * ldw + scol] : 0.f; if (kgain) w *= kgain[k0 + kk]; scr[kk * 33 + j] = w; }
    } else {
        const int n4 = (lane & 7) * 4;
#pragma unroll
        for (int i = 0; i < 8; ++i) { const int kk = (lane >> 3) + 8 * i; f32x4 w = *(const f32x4*)(W + (size_t)(k0 + kk) * ldw + sc0 + n4); if (kgain) w = w * kgain[k0 + kk];
            scr[kk * 33 + n4] = w[0]; scr[kk * 33 + n4 + 1] = w[1]; scr[kk * 33 + n4 + 2] = w[2]; scr[kk * 33 + n4 + 3] = w[3]; }
    }
    LDS_WAIT();
    const int c = lane & 7;
#pragma unroll
    for (int j = 0; j < 4; ++j) { const int n = (lane >> 3) + 8 * j; const LAS float* s = scr + (8 * c) * 33 + n;
        u32x4 o; o.x = cvt_pk_bf16(s[0 * 33], s[1 * 33]); o.y = cvt_pk_bf16(s[2 * 33], s[3 * 33]); o.z = cvt_pk_bf16(s[4 * 33], s[5 * 33]); o.w = cvt_pk_bf16(s[6 * 33], s[7 * 33]);
        *(u32x4*)(Wt + (size_t)(dr0 + n) * K + k0 + 8 * c) = o; }
    LDS_WAIT();
}
__device__ __forceinline__ void convert_rows_item(const float* W, const float* gain, bf16_t* D, int row, int lane) {
    const float g = gain[row];
#pragma unroll
    for (int j = 0; j < 2; ++j) { const float* p = W + (size_t)row * 1024 + 8 * lane + 512 * j; const f32x4 a = *(const f32x4*)p, b = *(const f32x4*)(p + 4);
        const float v[8] = {a[0] * g, a[1] * g, a[2] * g, a[3] * g, b[0] * g, b[1] * g, b[2] * g, b[3] * g}; *(u32x4*)(D + (size_t)row * 1024 + 8 * lane + 512 * j) = pack8(v); }
}
__device__ __forceinline__ void convert_attn_weights(const Frame& F, int l) {
    LAS float* scr = (LAS float*)(F.lds + F.wave * 16384);
    unsigned char* ws = F.ws + ((l & 1) ? WDELTA : 0);
    constexpr int I_IN = 72 * 16, I_UQ = 24 * 4, I_UKV = 32 * 2, I_SQ = 32 * 16, I_R = 1024;
    constexpr int NIT = I_IN + I_UQ + I_UKV + 2 * I_SQ + I_R;
    for (int it = F.gw; it < NIT; it += F.NGW) {
        int r = it;
        if (r < I_IN) { const int nb = r % 72, kb = r / 72, n0 = nb * 32;
            const bool mapped = (n0 >= 384 && n0 < 512) || (n0 >= 1536 && n0 < 2048 && ((n0 - 1536) & 63) == 0);
            if (mapped) transpose_item<true>(F.in(2) + (size_t)l * 1024 * D_IN, D_IN, 1024, kb * 64, 0, 32, (bf16_t*)(ws + WS_WIN), n0, scr, F.lane, F.in(17) + l * DM);
            else transpose_item(F.in(2) + (size_t)l * 1024 * D_IN, D_IN, 1024, kb * 64, win_src_col(n0), 32, (bf16_t*)(ws + WS_WIN), n0, scr, F.lane, F.in(17) + l * DM);
            continue; } r -= I_IN;
        if (r < I_UQ) { const int nb = r % 24, kb = r / 24;
            transpose_item(F.in(4) + (size_t)l * 256 * 768, 768, 256, kb * 64, nb * 32, 32, (bf16_t*)(ws + WS_WUQ), nb * 32, scr, F.lane, F.in(3) + l * 256); continue; } r -= I_UQ;
        if (r < I_UKV) { const int nb = r % 32, kb = r / 32, n0 = nb * 32; const int isv = n0 >= 512, nn = n0 - isv * 512, sc = (nn >> 6) * 128 + isv * 64 + (nn & 63);
            transpose_item(F.in(6) + (size_t)l * 128 * 1024, 1024, 128, kb * 64, sc, 32, (bf16_t*)(ws + WS_WUKV), n0, scr, F.lane, F.in(5) + l * 128); continue; } r -= I_UKV;
        if (r < 2 * I_SQ) { const int which = r / I_SQ, rr = r % I_SQ, nb = rr % 32, kb = rr / 32;
            const float* src = (which == 0 ? F.in(11) : F.in(14)) + (size_t)l * 1024 * 1024;
            bf16_t* dst = which == 0 ? (bf16_t*)(ws + WS_WOUT) : (bf16_t*)(F.ws + WS_WXOT);
            transpose_item(src, 1024, 1024, kb * 64, nb * 32, 32, dst, nb * 32, scr, F.lane); continue; } r -= 2 * I_SQ;
        convert_rows_item(F.in(12) + (size_t)l * 1024 * 1024, F.in(20) + l * DM, (bf16_t*)(F.ws + WS_WXQR), r, F.lane);
    }
}
__device__ __forceinline__ void convert_ffn_weights(const Frame& F, int l) {
    LAS float* scr = (LAS float*)(F.lds + F.wave * 16384);
    unsigned char* ws = F.ws;
    constexpr int I_GU = 176 * 16, I_DN = 32 * 44;
    for (int it = F.gw; it < I_GU + I_DN; it += F.NGW) {
        int r = it;
        if (r < I_GU) { const int nb = r % 176, kb = r / 176, n0 = nb * 32; const int tile = n0 >> 8, bj = (n0 >> 7) & 1, cc = n0 & 127, sc = bj * D_FF + tile * 128 + cc;
            transpose_item(F.in(15) + (size_t)l * 1024 * 2 * D_FF, 2 * D_FF, 1024, kb * 64, sc, 32, (bf16_t*)(ws + WS_WGU), n0, scr, F.lane, F.in(22) + l * DM); continue; } r -= I_GU;
        { const int nb = r % 32, kb = r / 32;
            transpose_item(F.in(16) + (size_t)l * D_FF * 1024, 1024, D_FF, kb * 64, nb * 32, 32, (bf16_t*)(ws + WS_WDN), nb * 32, scr, F.lane); }
    }
}

__device__ __forceinline__ void resid_init_phase(const Frame& F, const float* xin, bf16_t* XB, float* RSTD) {
    for (int row = F.gw; row < T; row += F.NGW) {
        float ss = 0.f;
#pragma unroll
        for (int j = 0; j < 2; ++j) { const float* p = xin + (size_t)row * DM + 8 * F.lane + 512 * j; const f32x4 a = *(const f32x4*)p, b = *(const f32x4*)(p + 4);
            const float v[8] = {a[0], a[1], a[2], a[3], b[0], b[1], b[2], b[3]};
#pragma unroll
            for (int e = 0; e < 8; ++e) ss += v[e] * v[e];
            *(u32x4*)(XB + (size_t)row * DM + 8 * F.lane + 512 * j) = pack8(v); }
        ss = wave_sum(ss);
        if (F.lane == 0) *(f32x4*)(RSTD + (size_t)row * 4) = (f32x4){ss, 0.f, 0.f, 0.f};
    }
}
constexpr int RN_ROWS = 4;
template <bool LAST>
__device__ __forceinline__ void resid_phase(const Frame& F, bf16_t* XB, const bf16_t* Y, const float* gpost, float* RSTD, float* OUT) {
    float g[2][8];
#pragma unroll
    for (int j = 0; j < 2; ++j)
#pragma unroll
        for (int e = 0; e < 8; ++e) g[j][e] = gpost[8 * F.lane + 512 * j + e];
    for (int row0 = F.gw; row0 < T; row0 += RN_ROWS * F.NGW) {
        u32x4 yw[RN_ROWS][2], xw[RN_ROWS][2];
#pragma unroll
        for (int rr = 0; rr < RN_ROWS; ++rr) { const int row = (row0 + rr * F.NGW < T) ? row0 + rr * F.NGW : row0;
#pragma unroll
            for (int j = 0; j < 2; ++j) { yw[rr][j] = *(const u32x4*)(Y + (size_t)row * DM + 8 * F.lane + 512 * j); xw[rr][j] = *(const u32x4*)(XB + (size_t)row * DM + 8 * F.lane + 512 * j); } }
#pragma unroll
        for (int rr = 0; rr < RN_ROWS; ++rr) { const int row = row0 + rr * F.NGW; if (row >= T) break;
            float yv[2][8], xv[2][8]; float ss = 0.f;
#pragma unroll
            for (int j = 0; j < 2; ++j) { unpack8(yw[rr][j], yv[j]); unpack8(xw[rr][j], xv[j]);
#pragma unroll
                for (int e = 0; e < 8; ++e) ss += yv[j][e] * yv[j][e]; }
            const float rstd = 1.0f / sqrtf(wave_sum(ss) * (1.0f / DM) + EPS);
            float s2 = 0.f;
#pragma unroll
            for (int j = 0; j < 2; ++j) {
#pragma unroll
                for (int e = 0; e < 8; ++e) { xv[j][e] += yv[j][e] * rstd * g[j][e]; s2 += xv[j][e] * xv[j][e]; }
                if (LAST) { float* p = OUT + (size_t)row * DM + 8 * F.lane + 512 * j; *(f32x4*)p = (f32x4){xv[j][0], xv[j][1], xv[j][2], xv[j][3]}; *(f32x4*)(p + 4) = (f32x4){xv[j][4], xv[j][5], xv[j][6], xv[j][7]}; }
                else *(u32x4*)(XB + (size_t)row * DM + 8 * F.lane + 512 * j) = pack8(xv[j]); }
            if (!LAST) { s2 = wave_sum(s2); if (F.lane == 0) RSTD[row] = 1.0f / sqrtf(s2 * (1.0f / DM) + EPS); }
        }
    }
}

__device__ __forceinline__ void prologue_rope(const Frame& F) {
    unsigned char* ws = F.ws;
    { const int gt = F.bx * 512 + F.tid, NT_ = F.G * 512;
      float* tmc = (float*)(ws + WS_TMC); float* tms = (float*)(ws + WS_TMS); float* tsc = (float*)(ws + WS_TSC); float* tss = (float*)(ws + WS_TSS);
      for (int e = gt; e < SEQ * 24; e += NT_) {
          const int pos = e / 24, k = e % 24; const bool mla = k < 16; const int i = mla ? k : k - 16; const float drot = mla ? 32.f : 16.f;
          const float inv = (float)pow(500000.0, -(double)(2 * i) / (double)drot);
          const float ang = (float)pos * inv;
          const double ad = (double)ang; const float c = (float)cos(ad), s = (float)sin(ad);
          if (mla) { tmc[pos * 16 + i] = c; tms[pos * 16 + i] = s; } else { tsc[pos * 8 + i] = c; tss[pos * 8 + i] = s; }
      } }
}
__device__ __forceinline__ void prologue_prereq(const Frame& F) {
    unsigned char* ws = F.ws;
    for (int rr = F.gw; rr < DEPTH * 512; rr += F.NGW) {
        const int l = rr >> 9, row = rr & 511; f32x4 v[4]; float ss = 0.f;
#pragma unroll
        for (int j = 0; j < 4; ++j) { v[j] = *(const f32x4*)(F.in(1) + (size_t)row * DM + 4 * F.lane + 256 * j); ss += (v[j][0] * v[j][0] + v[j][1] * v[j][1]) + (v[j][2] * v[j][2] + v[j][3] * v[j][3]); }
        const float rstd = 1.0f / sqrtf(wave_sum(ss) * (1.0f / DM) + EPS);
#pragma unroll
        for (int j = 0; j < 4; ++j) { const f32x4 g = *(const f32x4*)(F.in(19) + (size_t)l * DM + 4 * F.lane + 256 * j); const f32x4 h = v[j] * rstd * g; u32x2 w; w.x = cvt_pk_bf16(h[0], h[1]); w.y = cvt_pk_bf16(h[2], h[3]);
            *(u32x2*)((bf16_t*)(ws + WS_MEMN) + (size_t)rr * DM + 4 * F.lane + 256 * j) = w; }
    }
    { LAS float* scr = (LAS float*)(F.lds + F.wave * 16384);
      for (int it = F.gw; it < DEPTH * 64 * 16; it += F.NGW) { const int l = it / 1024, rr = it % 1024, nb = rr % 64, kb = rr / 64;
          transpose_item(F.in(13) + (size_t)l * 1024 * 2048, 2048, 1024, kb * 64, nb * 32, 32, (bf16_t*)(ws + WS_WXKVT) + (size_t)l * 2048 * 1024, nb * 32, scr, F.lane); } }
}

__device__ __forceinline__ float wave_scan_sum(float v, int lane) {
#pragma unroll
    for (int o = 1; o < 64; o <<= 1) { const float t = __shfl_up(v, o); if (lane >= o) v += t; }
    return v;
}
__device__ __forceinline__ float wave_scan_max(float v, int lane) {
#pragma unroll
    for (int o = 1; o < 64; o <<= 1) { const float t = __shfl_up(v, o); if (lane >= o) v = fmaxf(v, t); }
    return v;
}
constexpr int ML_STR = 144;
constexpr int ML_GRP_BYTES = 49152;
constexpr int ML_K = 0, ML_V = 18432, ML_C = 36864, ML_F = 46080;

__device__ __forceinline__ void ml1_phase(const Frame& F, const float* convw, const float* convb) {
    unsigned char* ws = F.ws; const int lane = F.lane, grp = F.wave >> 2, gwv = F.wave & 3, gt = F.tid & 255;
    const bf16_t* PROJ = (const bf16_t*)(ws + WS_PROJ); bf16_t* MLQK = (bf16_t*)(ws + WS_MLQK); const float* GATE = (const float*)(ws + WS_GATE);
    float* MLU = (float*)(ws + WS_MLU); float* MLB = (float*)(ws + WS_MLB);
    LAS unsigned char* L = F.lds + grp * ML_GRP_BYTES; LAS float* fs = (LAS float*)(L + ML_F);
    const int r = lane & 31, hi = lane >> 5, blk = (lane >> 4) & 1, q = (lane & 15) >> 2, pp = lane & 3;
    for (int it = 0; ; ++it) {
        const int pair = it * F.G + F.bx; if (pair >= 512) break;
        const int chunk = pair * 2 + grp, bh = chunk >> 7, c = chunk & 127, b = bh >> 2, head = bh & 3; const size_t tok0 = (size_t)b * SEQ + c * 128;
        u32x4 wq[4][4], wk[4][4], wv[4];
#pragma unroll
        for (int i = 0; i < 4; ++i) { const int s = (gt >> 3) + 32 * i, ch = gt & 7;
#pragma unroll
            for (int j = 0; j < 4; ++j) { const int dp = (c * 128 + s + j - 3 >= 0) ? j - 3 : 0; const bf16_t* p = PROJ + (ptrdiff_t)(tok0 + s + dp) * D_INP + head * 64 + ch * 8;
                wq[i][j] = *(const u32x4*)(p + C_MLQ); wk[i][j] = *(const u32x4*)(p + C_MLK); }
            wv[i] = *(const u32x4*)(PROJ + (tok0 + s) * D_INP + C_MLV + head * 64 + ch * 8); }
        if (gwv == 0) {
            const float lf0 = GATE[(tok0 + lane) * 8 + 4 + head], lf1 = GATE[(tok0 + 64 + lane) * 8 + 4 + head];
            const float li0 = GATE[(tok0 + lane) * 8 + head], li1 = GATE[(tok0 + 64 + lane) * 8 + head];
            const float b0 = wave_scan_sum(lf0, lane); const float carry = __shfl(b0, 63); const float b1 = wave_scan_sum(lf1, lane) + carry;
            const float bL = __shfl(b1, 63);
            const float g0 = bL - b0 + li0, g1 = bL - b1 + li1;
            float mx = fmaxf(g0, g1);
#pragma unroll
            for (int o = 1; o < 64; o <<= 1) mx = fmaxf(mx, __shfl_xor(mx, o));
            fs[lane] = expf(g0 - mx); fs[64 + lane] = expf(g1 - mx);
            if (lane == 0) { MLB[chunk * 2] = bL; MLB[chunk * 2 + 1] = mx; }
        }
        __syncthreads();
#pragma unroll
        for (int qk = 0; qk < 2; ++qk) {
            const int ch = gt & 7, cch = qk * 256 + head * 64 + ch * 8;
            float cw[4][8], cb[8];
#pragma unroll
            for (int j = 0; j < 4; ++j)
#pragma unroll
                for (int e = 0; e < 8; ++e) cw[j][e] = convw[j * 512 + cch + e];
#pragma unroll
            for (int e = 0; e < 8; ++e) cb[e] = convb[cch + e];
            const float ksc = qk ? 0.125f : 1.0f;
#pragma unroll
            for (int i = 0; i < 4; ++i) { const int s = (gt >> 3) + 32 * i;
                float a[8];
#pragma unroll
                for (int e = 0; e < 8; ++e) a[e] = cb[e];
#pragma unroll
                for (int j = 0; j < 4; ++j) { const int dp = j - 3;
                    if (c * 128 + s + dp >= 0) { const u32x4 w = qk ? wk[i][j] : wq[i][j];
                        a[0] += cw[j][0] * bflo(w.x); a[1] += cw[j][1] * bfhi(w.x); a[2] += cw[j][2] * bflo(w.y); a[3] += cw[j][3] * bfhi(w.y);
                        a[4] += cw[j][4] * bflo(w.z); a[5] += cw[j][5] * bfhi(w.z); a[6] += cw[j][6] * bflo(w.w); a[7] += cw[j][7] * bfhi(w.w); } }
#pragma unroll
                for (int e = 0; e < 8; ++e) a[e] = a[e] * frcp(1.f + fexp2(-a[e] * LOG2E)) * ksc;
                const u32x4 kb = pack8(a);
                *(u32x4*)(MLQK + (tok0 + s) * 512 + qk * 256 + head * 64 + ch * 8) = kb;
                if (qk) { const float w = fs[s];
                    u32x4 o; o.x = cvt_pk_bf16(bflo(kb.x) * w, bfhi(kb.x) * w); o.y = cvt_pk_bf16(bflo(kb.y) * w, bfhi(kb.y) * w); o.z = cvt_pk_bf16(bflo(kb.z) * w, bfhi(kb.z) * w); o.w = cvt_pk_bf16(bflo(kb.w) * w, bfhi(kb.w) * w);
                    *(LAS u32x4*)(L + ML_K + s * ML_STR + ch * 16) = o;
                    *(LAS u32x4*)(L + ML_V + s * ML_STR + ch * 16) = wv[i]; }
            }
        }
        __syncthreads();
        { const int vi = gwv >> 1, kj = gwv & 1; f32x16 acc = {};
#pragma unroll
          for (int ks = 0; ks < 8; ++ks) {
              const int row = 16 * ks + 8 * hi + q;
              const LAS unsigned char* pa = L + ML_V + row * ML_STR + (32 * vi + 16 * blk + 4 * pp) * 2;
              const LAS unsigned char* pb = L + ML_K + row * ML_STR + (32 * kj + 16 * blk + 4 * pp) * 2;
              const bf16x8 A = cat4(tr_read(pa), tr_read(pa + 4 * ML_STR)), B = cat4(tr_read(pb), tr_read(pb + 4 * ML_STR));
              acc = __builtin_amdgcn_mfma_f32_32x32x16_bf16(A, B, acc, 0, 0, 0);
          }
          float* U = MLU + (size_t)chunk * 4160;
#pragma unroll
          for (int reg = 0; reg < 16; ++reg) U[(32 * vi + crow(reg, hi)) * 64 + 32 * kj + r] = acc[reg];
        }
        if (gt < 64) { float s = 0.f;
            for (int t = 0; t < 128; ++t) s += bf2f(*(const LAS bf16_t*)(L + ML_K + t * ML_STR + gt * 2));
            MLU[(size_t)chunk * 4160 + 4096 + gt] = s; }
        __syncthreads();
    }
}
constexpr int ML2_WGS = (8 * 4160 + 511) / 512;
__device__ __forceinline__ void ml2_phase(const Frame& F) {
    unsigned char* ws = F.ws;
    const float* MLU = (const float*)(ws + WS_MLU); const float* MLB = (const float*)(ws + WS_MLB);
    bf16_t* MLC = (bf16_t*)(ws + WS_MLC); float* MLN = (float*)(ws + WS_MLN); float* MLM = (float*)(ws + WS_MLM);
    const int gt = F.bx * 512 + F.tid;
    if (gt >= 8 * 4160) return;
    const int bh = gt / 4160, e = gt % 4160;
    float st = 0.f, m = -1e30f;
    for (int c0 = 0; c0 < 128; c0 += 32) {
        float u[32], bl[32], ml[32];
#pragma unroll
        for (int j = 0; j < 32; ++j) { const int chunk = bh * 128 + c0 + j; u[j] = MLU[(size_t)chunk * 4160 + e]; bl[j] = MLB[chunk * 2]; ml[j] = MLB[chunk * 2 + 1]; }
#pragma unroll
        for (int j = 0; j < 32; ++j) { const int chunk = bh * 128 + c0 + j;
            if (e < 4096) MLC[(size_t)chunk * 4096 + e] = f2bf(st); else MLN[chunk * 64 + e - 4096] = st;
            if (e == 0) MLM[chunk] = m;
            const float mn = fmaxf(bl[j] + m, ml[j]);
            st = fexp2((bl[j] + m - mn) * LOG2E) * st + fexp2((ml[j] - mn) * LOG2E) * u[j]; m = mn; }
    }
}
__device__ __forceinline__ void ml3_phase(const Frame& F) {
    unsigned char* ws = F.ws; const int lane = F.lane, grp = F.wave >> 2, gwv = F.wave & 3, gt = F.tid & 255;
    const bf16_t* PROJ = (const bf16_t*)(ws + WS_PROJ); const bf16_t* MLQK = (const bf16_t*)(ws + WS_MLQK); const float* GATE = (const float*)(ws + WS_GATE);
    const bf16_t* MLC = (const bf16_t*)(ws + WS_MLC); const float* MLN = (const float*)(ws + WS_MLN); const float* MLM = (const float*)(ws + WS_MLM);
    bf16_t* MIX = (bf16_t*)*(float* const CAS*)(F.kp + 192);
    LAS unsigned char* L = F.lds + grp * ML_GRP_BYTES; LAS float* fa = (LAS float*)(L + ML_F); LAS float* frt = fa + 128; LAS float* fwi = fa + 256; LAS float* fem = fa + 384; LAS float* fn = fa + 512;
    const int r = lane & 31, hi = lane >> 5, blk = (lane >> 4) & 1, q = (lane & 15) >> 2, pp = lane & 3;
    for (int it = 0; ; ++it) {
        const int pair = it * F.G + F.bx; if (pair >= 512) break;
        const int chunk = pair * 2 + grp, bh = chunk >> 7, c = chunk & 127, b = bh >> 2, head = bh & 3; const size_t tok0 = (size_t)b * SEQ + c * 128;
        if (gwv == 0) {
            const float lf0 = GATE[(tok0 + lane) * 8 + 4 + head], lf1 = GATE[(tok0 + 64 + lane) * 8 + 4 + head];
            const float li0 = GATE[(tok0 + lane) * 8 + head], li1 = GATE[(tok0 + 64 + lane) * 8 + head];
            const float b0 = wave_scan_sum(lf0, lane); const float carry = __shfl(b0, 63); const float b1 = wave_scan_sum(lf1, lane) + carry;
            const float a0 = li0 - b0, a1 = li1 - b1;
            const float p0 = wave_scan_max(a0, lane); const float pc = __shfl(p0, 63); const float p1 = fmaxf(wave_scan_max(a1, lane), pc);
            const float m = MLM[chunk];
            const float mt0 = fmaxf(b0 + m, b0 + p0), mt1 = fmaxf(b1 + m, b1 + p1);
            fa[lane] = a0; fa[64 + lane] = a1; frt[lane] = b0 - mt0; frt[64 + lane] = b1 - mt1;
            fwi[lane] = expf(b0 + m - mt0); fwi[64 + lane] = expf(b1 + m - mt1); fem[lane] = expf(-mt0); fem[64 + lane] = expf(-mt1);
        }
#pragma unroll
        for (int i = 0; i < 4; ++i) { const int id = gt + 256 * i, s = id >> 3, ch = id & 7;
            *(LAS u32x4*)(L + ML_K + s * ML_STR + ch * 16) = *(const u32x4*)(MLQK + (tok0 + s) * 512 + 256 + head * 64 + ch * 8);
            *(LAS u32x4*)(L + ML_V + s * ML_STR + ch * 16) = *(const u32x4*)(PROJ + (tok0 + s) * D_INP + C_MLV + head * 64 + ch * 8); }
#pragma unroll
        for (int i = 0; i < 2; ++i) { const int id = gt + 256 * i, v = id >> 3, ch = id & 7;
            *(LAS u32x4*)(L + ML_C + v * ML_STR + ch * 16) = *(const u32x4*)(MLC + (size_t)chunk * 4096 + v * 64 + ch * 8); }
        if (gt < 64) fn[gt] = MLN[chunk * 64 + gt];
        __syncthreads();
        {
            const int tq = 32 * gwv + r; const size_t tokq = tok0 + tq;
            bf16x8 qf[4]; float qn = 0.f;
#pragma unroll
            for (int s = 0; s < 4; ++s) { qf[s] = *(const bf16x8*)(MLQK + tokq * 512 + head * 64 + 16 * s + 8 * hi);
#pragma unroll
                for (int j = 0; j < 8; ++j) qn += bf2f((unsigned short)qf[s][j]) * fn[16 * s + 8 * hi + j]; }
            qn += __shfl_xor(qn, 32);
            f32x16 acc[2] = {{}, {}};
#pragma unroll
            for (int dvb = 0; dvb < 2; ++dvb)
#pragma unroll
                for (int s = 0; s < 4; ++s) { const bf16x8 A = *(const LAS bf16x8*)(L + ML_C + (32 * dvb + r) * ML_STR + (16 * s + 8 * hi) * 2);
                    acc[dvb] = __builtin_amdgcn_mfma_f32_32x32x16_bf16(A, qf[s], acc[dvb], 0, 0, 0); }
            const float wi = fwi[tq], rt = frt[tq];
            acc[0] = acc[0] * wi; acc[1] = acc[1] * wi;
            float sintra = 0.f;
            for (int kb = 0; kb <= gwv; ++kb) {
                f32x16 st = {};
#pragma unroll
                for (int s = 0; s < 4; ++s) { const bf16x8 A = *(const LAS bf16x8*)(L + ML_K + (32 * kb + r) * ML_STR + (16 * s + 8 * hi) * 2);
                    st = __builtin_amdgcn_mfma_f32_32x32x16_bf16(A, qf[s], st, 0, 0, 0); }
#pragma unroll
                for (int reg = 0; reg < 16; ++reg) { const int c = 32 * kb + (reg & 3) + 8 * (reg >> 2);
                    const float w = (c <= tq - 4 * hi) ? fexp2((rt + fa[c + 4 * hi]) * LOG2E) : 0.f; const float pv = st[reg] * w; st[reg] = pv; sintra += pv; }
#pragma unroll
                for (int sp = 0; sp < 2; ++sp) {
                    u32x4 pw; pw.x = cvt_pk_bf16(st[8 * sp + 0], st[8 * sp + 1]); pw.y = cvt_pk_bf16(st[8 * sp + 2], st[8 * sp + 3]); pw.z = cvt_pk_bf16(st[8 * sp + 4], st[8 * sp + 5]); pw.w = cvt_pk_bf16(st[8 * sp + 6], st[8 * sp + 7]);
                    const bf16x8 P = __builtin_bit_cast(bf16x8, pw);
#pragma unroll
                    for (int dvb = 0; dvb < 2; ++dvb) { const LAS unsigned char* pa = L + ML_V + (32 * kb + 16 * sp + 4 * hi + q) * ML_STR + (32 * dvb + 16 * blk + 4 * pp) * 2;
                        const bf16x8 A = cat4(tr_read(pa), tr_read(pa + 8 * ML_STR));
                        acc[dvb] = __builtin_amdgcn_mfma_f32_32x32x16_bf16(A, P, acc[dvb], 0, 0, 0); }
                }
            }
            sintra += __shfl_xor(sintra, 32);
            const float nq = wi * qn + sintra; const float inv = 1.0f / fmaxf(fabsf(nq), fem[tq]);
#pragma unroll
            for (int dvb = 0; dvb < 2; ++dvb)
#pragma unroll
                for (int g = 0; g < 4; ++g) { const int v = 32 * dvb + 8 * g + 4 * hi;
                    const u32x2 ow = *(const u32x2*)(PROJ + tokq * D_INP + C_MLO + head * 64 + v);
                    const float o0 = bflo(ow.x), o1 = bfhi(ow.x), o2 = bflo(ow.y), o3 = bfhi(ow.y);
                    const float h0 = acc[dvb][4 * g + 0] * inv * frcp(1.f + fexp2(-o0 * LOG2E)), h1 = acc[dvb][4 * g + 1] * inv * frcp(1.f + fexp2(-o1 * LOG2E));
                    const float h2 = acc[dvb][4 * g + 2] * inv * frcp(1.f + fexp2(-o2 * LOG2E)), h3 = acc[dvb][4 * g + 3] * inv * frcp(1.f + fexp2(-o3 * LOG2E));
                    u32x2 w; w.x = cvt_pk_bf16(h0, h1); w.y = cvt_pk_bf16(h2, h3);
                    *(u32x2*)(MIX + tokq * 1024 + 512 + head * 64 + v) = w; }
        }
        __syncthreads();
    }
}

template <int NKB, int VSTR>
__device__ __forceinline__ void softmax_pv(f32x16 (&st)[NKB], const unsigned (&vm)[NKB], bool masked, float& m, float& l, f32x16 (&o)[2], const LAS unsigned char* vt, int hi, int blk, int q, int pp) {
    float mx = -1e30f;
#pragma unroll
    for (int kb = 0; kb < NKB; ++kb)
#pragma unroll
        for (int reg = 0; reg < 16; ++reg) mx = fmaxf(mx, st[kb][reg]);
    mx = fmaxf(mx, __shfl_xor(mx, 32));
    const float mn = fmaxf(m, mx), alpha = fexp2(m - mn);
    m = mn; l *= alpha; o[0] = o[0] * alpha; o[1] = o[1] * alpha;
    float ls = 0.f;
#pragma unroll
    for (int kb = 0; kb < NKB; ++kb)
#pragma unroll
        for (int reg = 0; reg < 16; ++reg) { float p = fexp2(st[kb][reg] - mn); if (masked && !((vm[kb] >> reg) & 1u)) p = 0.f; st[kb][reg] = p; ls += p; }
    l += ls;
#pragma unroll
    for (int kb = 0; kb < NKB; ++kb)
#pragma unroll
        for (int sp = 0; sp < 2; ++sp) {
            u32x4 pw; pw.x = cvt_pk_bf16(st[kb][8 * sp + 0], st[kb][8 * sp + 1]); pw.y = cvt_pk_bf16(st[kb][8 * sp + 2], st[kb][8 * sp + 3]); pw.z = cvt_pk_bf16(st[kb][8 * sp + 4], st[kb][8 * sp + 5]); pw.w = cvt_pk_bf16(st[kb][8 * sp + 6], st[kb][8 * sp + 7]);
            const bf16x8 P = __builtin_bit_cast(bf16x8, pw);
#pragma unroll
            for (int dvb = 0; dvb < 2; ++dvb) { const LAS unsigned char* pa = vt + (32 * kb + 16 * sp + 4 * hi + q) * VSTR + (32 * dvb + 16 * blk + 4 * pp) * 2;
                const bf16x8 A = cat4(tr_read(pa), tr_read(pa + 8 * VSTR));
                o[dvb] = __builtin_amdgcn_mfma_f32_32x32x16_bf16(A, P, o[dvb], 0, 0, 0); }
        }
}

constexpr int MLA_KSTR = 208, MLA_VSTR = 192, MLA_KB = 64 * MLA_KSTR, MLA_VB = 64 * MLA_VSTR, MLA_VOFF = 2 * MLA_KB;
constexpr float MLA_THR = 8.0f, MLA_HEAD = 7.f;
struct MlaState { float m, l; };
typedef __bf16 bf16x2_t __attribute__((ext_vector_type(2)));
__device__ __forceinline__ float dot2ones(unsigned w, float acc) { return __builtin_amdgcn_fdot2_f32_bf16(__builtin_bit_cast(bf16x2_t, w), __builtin_bit_cast(bf16x2_t, 0x3f803f80u), acc, false); }
__device__ __forceinline__ float max3f(float a, float b, float c) { return __builtin_fmaxf(__builtin_fmaxf(a, b), c); }
__device__ __forceinline__ float swapmax32(float v) {
    auto rr = __builtin_amdgcn_permlane32_swap(__float_as_uint(v), __float_as_uint(v), false, false);
    return fmaxf(__uint_as_float(rr[0]), __uint_as_float(rr[1]));
}
__device__ __forceinline__ void mla_mask(int t, int qw0, int qi, int hi, f32x16 (&C)[2]) {
    if (64 * t + 63 > qw0) {
        int d2 = qi - 64 * t - 4 * hi; asm volatile("" : "+v"(d2));
#pragma unroll
        for (int kb = 0; kb < 2; ++kb)
#pragma unroll
            for (int reg = 0; reg < 16; ++reg) C[kb][reg] = (32 * kb + (reg & 3) + 8 * (reg >> 2) > d2) ? -1e30f : C[kb][reg];
    }
}
__device__ __forceinline__ float mla_rowmax(const f32x16 (&C)[2]) {
    float mxa = max3f(C[0][0], C[0][1], C[1][0]), mxb = max3f(C[0][2], C[0][3], C[1][1]); mxa = max3f(mxa, C[1][2], C[1][3]);
#pragma unroll
    for (int reg = 4; reg < 16; reg += 4) { mxa = max3f(mxa, C[0][reg], C[0][reg + 1]); mxb = max3f(mxb, C[0][reg + 2], C[0][reg + 3]); mxa = max3f(mxa, C[1][reg], C[1][reg + 1]); mxb = max3f(mxb, C[1][reg + 2], C[1][reg + 3]); }
    return swapmax32(fmaxf(mxa, mxb));
}
__device__ __forceinline__ void mla_pack(const f32x16 (&P)[2], u32x4 (&pf)[2][2]) {
#pragma unroll
    for (int kb = 0; kb < 2; ++kb)
#pragma unroll
        for (int sp = 0; sp < 2; ++sp) { pf[kb][sp].x = cvt_pk_bf16(P[kb][8 * sp + 0], P[kb][8 * sp + 1]); pf[kb][sp].y = cvt_pk_bf16(P[kb][8 * sp + 2], P[kb][8 * sp + 3]);
            pf[kb][sp].z = cvt_pk_bf16(P[kb][8 * sp + 4], P[kb][8 * sp + 5]); pf[kb][sp].w = cvt_pk_bf16(P[kb][8 * sp + 6], P[kb][8 * sp + 7]); }
}
__device__ __forceinline__ float mla_rowsum(const u32x4 (&pf)[2][2]) {
    float s0 = 0.f, s1 = 0.f;
#pragma unroll
    for (int kb = 0; kb < 2; ++kb)
#pragma unroll
        for (int sp = 0; sp < 2; ++sp) { s0 = dot2ones(pf[kb][sp].x, s0); s1 = dot2ones(pf[kb][sp].y, s1); s0 = dot2ones(pf[kb][sp].z, s0); s1 = dot2ones(pf[kb][sp].w, s1); }
    return s0 + s1;
}
__device__ __forceinline__ void mla_qk(const LAS unsigned char* kbuf, const bf16x8 (&qf)[6], const f32x16& negm, f32x16 (&C)[2], int r, int hi) {
#pragma unroll
    for (int s = 0; s < 6; ++s)
#pragma unroll
        for (int kb = 0; kb < 2; ++kb) { const bf16x8 A = *(const LAS bf16x8*)(kbuf + (32 * kb + r) * MLA_KSTR + (16 * s + 8 * hi) * 2);
            C[kb] = __builtin_amdgcn_mfma_f32_32x32x16_bf16(A, qf[s], s == 0 ? negm : C[kb], 0, 0, 0); }
}
__device__ __forceinline__ void mla_pv(const LAS unsigned char* vbuf, const u32x4 (&pf)[2][2], f32x16 (&o)[2], int hi, int blk, int q, int pp) {
    const LAS unsigned char* pv0 = vbuf + (4 * hi + q) * MLA_VSTR + (16 * blk + 4 * pp) * 2;
#pragma unroll
    for (int k = 0; k < 4; ++k) {
        const LAS unsigned char* pk = pv0 + (16 * k) * MLA_VSTR;
        const bf16x8 v0 = cat4(tr_read(pk), tr_read(pk + 8 * MLA_VSTR)), v1 = cat4(tr_read(pk + 64), tr_read(pk + 64 + 8 * MLA_VSTR));
        const bf16x8 P = __builtin_bit_cast(bf16x8, pf[k >> 1][k & 1]);
        o[0] = __builtin_amdgcn_mfma_f32_32x32x16_bf16(v0, P, o[0], 0, 0, 0);
        o[1] = __builtin_amdgcn_mfma_f32_32x32x16_bf16(v1, P, o[1], 0, 0, 0);
    }
}
template <bool DOQK, bool DOPV>
__device__ __forceinline__ bf16x8 mla_frag(int i, const LAS unsigned char* pk0, const LAS unsigned char* pv0) {
    if (i < 8) { if (!DOPV) return bf16x8{}; const LAS unsigned char* p = pv0 + (16 * (i >> 1)) * MLA_VSTR + 64 * (i & 1); return cat4(tr_read(p), tr_read(p + 8 * MLA_VSTR)); }
    if (!DOQK) return bf16x8{};
    const int j = i - 8; return *(const LAS bf16x8*)(pk0 + 32 * (j & 1) * MLA_KSTR + 32 * (j >> 1));
}
struct MlaStage { u32x4 rk[2], rv[2]; u32x2 rr[2]; };
template <bool DOQK, bool DOPV, bool DOSM, bool DOSTG, bool DOPRE, bool HAVEPRE, int TP>
__device__ __forceinline__ void mla_step(int tp, int qw0, int qi, const LAS unsigned char* lk0, const LAS unsigned char* lv0, const bf16x8 (&qf)[6], f32x16& negm, f32x16 (&o)[2], MlaState& S,
                                         f32x16 (&C)[2], f32x16 (&Pp)[2], const u32x4 (&pfin)[2][2], u32x4 (&pfout)[2][2], bf16x8 (&vpre)[3], MlaStage& G,
                                         LAS unsigned char* lkw, LAS unsigned char* lkr, LAS unsigned char* lvw, const char* gk0, const char* gk1, const char* gr0, const char* gr1, const char* gv0, const char* gv1,
                                         unsigned gvo, unsigned gro, int hi) {
    if (DOSM) mla_mask(tp, qw0, qi, hi, Pp);
    const LAS unsigned char* const pk0 = lk0 + TP * MLA_KB;
    const LAS unsigned char* const pv0 = lv0 + ((TP + 2) & 3) * MLA_VB;
    const LAS unsigned char* const pn0 = lv0 + ((TP + 3) & 3) * MLA_VB;
    if (DOSTG) {
        *(LAS u32x4*)(lkw + ((TP + 2) & 3) * MLA_KB) = G.rk[0]; *(LAS u32x2*)(lkr + ((TP + 2) & 3) * MLA_KB) = G.rr[0]; *(LAS u32x4*)(lkw + ((TP + 3) & 3) * MLA_KB) = G.rk[1]; *(LAS u32x2*)(lkr + ((TP + 3) & 3) * MLA_KB) = G.rr[1];
        *(LAS u32x4*)(lvw + TP * MLA_VB) = G.rv[0]; *(LAS u32x4*)(lvw + ((TP + 1) & 3) * MLA_VB) = G.rv[1];
        unsigned vk = gvo, vr = gro; asm volatile("" : "+v"(vk), "+v"(vr));
        G.rk[0] = *(const u32x4*)(gk0 + vk); G.rr[0] = *(const u32x2*)(gr0 + vr); G.rk[1] = *(const u32x4*)(gk1 + vk); G.rr[1] = *(const u32x2*)(gr1 + vr);
        G.rv[0] = *(const u32x4*)(gv0 + vk); G.rv[1] = *(const u32x4*)(gv1 + vk);
    }
    constexpr int MO[23] = {0, 1, 2, 8, 3, 9, 4, 10, 5, 11, 6, 12, 7, 13, 14, 15, 16, 17, 18, 19, 20, 20, 20};
    bf16x8 fr[23];
    float s0 = 0.f, s1 = 0.f;
    unsigned pw[16];
    if (DOPV && HAVEPRE) { fr[0] = vpre[0]; fr[1] = vpre[1]; fr[2] = vpre[2]; }
    else { fr[0] = mla_frag<DOQK, DOPV>(MO[0], pk0, pv0); fr[1] = mla_frag<DOQK, DOPV>(MO[1], pk0, pv0); fr[2] = mla_frag<DOQK, DOPV>(MO[2], pk0, pv0); }
    __builtin_amdgcn_sched_barrier(0);
#pragma unroll
    for (int i = 0; i < 20; ++i) {
        if (i + 3 < 20) fr[i + 3] = mla_frag<DOQK, DOPV>(MO[i + 3], pk0, pv0);
        if (DOPRE && i >= 17) vpre[i - 17] = mla_frag<false, true>(i - 17, pn0, pn0);
        { const int mi = MO[i];
          if (mi < 8) { if (DOPV) o[mi & 1] = __builtin_amdgcn_mfma_f32_32x32x16_bf16(fr[i], __builtin_bit_cast(bf16x8, pfin[mi >> 2][(mi >> 1) & 1]), o[mi & 1], 0, 0, 0); }
          else if (DOQK) { const int j = mi - 8, s = j >> 1, kb = j & 1; C[kb] = __builtin_amdgcn_mfma_f32_32x32x16_bf16(fr[i], qf[s], s == 0 ? negm : C[kb], 0, 0, 0); } }
        if (DOSM) {
            if (i < 16) { const int kb = i >> 3, reg = 2 * (i & 7); Pp[kb][reg] = fexp2(Pp[kb][reg]); Pp[kb][reg + 1] = fexp2(Pp[kb][reg + 1]); }
            if (i >= 2 && i < 18) { const int e = i - 2, kb = e >> 3, reg = 2 * (e & 7); pw[e] = cvt_pk_bf16(Pp[kb][reg], Pp[kb][reg + 1]); }
            if (i >= 3 && i < 19) { const int e = i - 3; if (e & 1) s1 = dot2ones(pw[e], s1); else s0 = dot2ones(pw[e], s0); }
        }
        __builtin_amdgcn_sched_barrier(0);
    }
    if (DOSM) {
#pragma unroll
        for (int kb = 0; kb < 2; ++kb)
#pragma unroll
            for (int sp = 0; sp < 2; ++sp) { pfout[kb][sp].x = pw[8 * kb + 4 * sp]; pfout[kb][sp].y = pw[8 * kb + 4 * sp + 1]; pfout[kb][sp].z = pw[8 * kb + 4 * sp + 2]; pfout[kb][sp].w = pw[8 * kb + 4 * sp + 3]; }
        const float ts = s0 + s1; S.l += ts;
        if (__any(ts >= 2.0f)) {
            const float dl = fmaxf(flog2(mla_rowmax(Pp)) + MLA_HEAD, 0.f), f = fexp2(-dl);
            S.m += dl; S.l *= f;
#pragma unroll
            for (int reg = 0; reg < 16; ++reg) negm[reg] = -S.m;
            asm volatile("" : "+v"(negm));
            Pp[0] = Pp[0] * f; Pp[1] = Pp[1] * f; mla_pack(Pp, pfout);
            o[0] = o[0] * f; o[1] = o[1] * f;
            if (DOQK) {
#pragma unroll
                for (int kb = 0; kb < 2; ++kb)
#pragma unroll
                    for (int reg = 0; reg < 16; ++reg) C[kb][reg] -= dl; }
        }
    }
}
constexpr int MLA_VOFF4 = 4 * MLA_KB;
__device__ __forceinline__ void mla_unit(const Frame& F, int b, int h, int qb) {
    int tid_ = F.tid; asm volatile("" : "+v"(tid_));
    unsigned char* ws = F.ws; const int tid = tid_, lane = tid & 63, wid = F.wave;
    const bf16_t* Q = (const bf16_t*)(ws + WS_Q); const bf16_t* KV = (const bf16_t*)(ws + WS_KV); const bf16_t* KPE = (const bf16_t*)(ws + WS_KPE); bf16_t* MIX = (bf16_t*)*(float* const CAS*)(F.kp + 192);
    const int r = lane & 31, hi = lane >> 5, blk = (lane >> 4) & 1, q = (lane & 15) >> 2, pp = lane & 3;
    const size_t rowb = (size_t)b * SEQ; const int qw0 = qb * 256 + wid * 32, qi = qw0 + r;
    bf16x8 qf[6];
#pragma unroll
    for (int s = 0; s < 6; ++s) qf[s] = *(const bf16x8*)(Q + (rowb + qi) * 768 + h * 96 + 16 * s + 8 * hi);
    const int srow = tid >> 3, sch = tid & 7;
    const unsigned voK = (unsigned)(srow * 1024 + sch * 8) * 2u, voR = (unsigned)(srow * 32 + sch * 4) * 2u;
    const char* const bK = (const char*)(KV + rowb * 1024 + h * 64); const char* const bV = bK + 512 * 2; const char* const bR = (const char*)(KPE + rowb * 32);
    const int NT = 4 * (qb + 1);
    LAS unsigned char* const L = F.lds;
    const int kwo = srow * MLA_KSTR + sch * 16, kro = srow * MLA_KSTR + 128 + sch * 8, vwo = MLA_VOFF4 + srow * MLA_VSTR + sch * 16;
#define MLA_LDK(tile) (*(const u32x4*)(bK + (size_t)(tile) * (64 * 1024 * 2) + voK))
#define MLA_LDV(tile) (*(const u32x4*)(bV + (size_t)(tile) * (64 * 1024 * 2) + voK))
#define MLA_LDR(tile) (*(const u32x2*)(bR + (size_t)(tile) * (64 * 32 * 2) + voR))
#define MLA_BAR() do { asm volatile("s_waitcnt lgkmcnt(0)" ::: "memory"); __builtin_amdgcn_s_barrier(); asm volatile("" ::: "memory"); } while (0)
    MlaStage G;
    { const u32x4 k0 = MLA_LDK(0), k1 = MLA_LDK(1); const u32x2 r0 = MLA_LDR(0), r1 = MLA_LDR(1);
      G.rk[0] = MLA_LDK(2); G.rr[0] = MLA_LDR(2); G.rk[1] = MLA_LDK(3); G.rr[1] = MLA_LDR(3); G.rv[0] = MLA_LDV(0); G.rv[1] = MLA_LDV(1);
      *(LAS u32x4*)(L + kwo) = k0; *(LAS u32x2*)(L + kro) = r0; *(LAS u32x4*)(L + MLA_KB + kwo) = k1; *(LAS u32x2*)(L + MLA_KB + kro) = r1; }
    MLA_BAR();
    int ko = r * MLA_KSTR + 16 * hi, vo = (4 * hi + q) * MLA_VSTR + (16 * blk + 4 * pp) * 2; asm volatile("" : "+v"(ko), "+v"(vo));
    MlaState S; S.m = 0.f; S.l = 0.f;
    f32x16 negm = {}, o[2] = {{}, {}}, CA[2], CB[2];
    u32x4 pfE[2][2], pfO[2][2];
    bf16x8 vpre[3];
    const LAS unsigned char* lk0; const LAS unsigned char* lv0; LAS unsigned char* lkw; LAS unsigned char* lkr; LAS unsigned char* lvw;
    { unsigned a0 = (unsigned)(size_t)L + (unsigned)ko, a1 = (unsigned)(size_t)L + (unsigned)kwo, a2 = (unsigned)(size_t)L + (unsigned)kro, a3 = (unsigned)(size_t)L + (unsigned)(MLA_VOFF4 + vo), a4 = (unsigned)(size_t)L + (unsigned)vwo;
      asm volatile("" : "+v"(a0), "+v"(a1), "+v"(a2), "+v"(a3), "+v"(a4));
      lk0 = (const LAS unsigned char*)(size_t)a0; lkw = (LAS unsigned char*)(size_t)a1; lkr = (LAS unsigned char*)(size_t)a2; lv0 = (const LAS unsigned char*)(size_t)a3; lvw = (LAS unsigned char*)(size_t)a4; }
    { *(LAS u32x4*)(L + 2 * MLA_KB + kwo) = G.rk[0]; *(LAS u32x2*)(L + 2 * MLA_KB + kro) = G.rr[0]; *(LAS u32x4*)(L + 3 * MLA_KB + kwo) = G.rk[1]; *(LAS u32x2*)(L + 3 * MLA_KB + kro) = G.rr[1];
      *(LAS u32x4*)(L + vwo) = G.rv[0]; *(LAS u32x4*)(L + MLA_VB + vwo) = G.rv[1];
      const int t4 = 4 < NT ? 4 : NT - 1, t5 = 5 < NT ? 5 : NT - 1;
      G.rk[0] = MLA_LDK(t4); G.rr[0] = MLA_LDR(t4); G.rk[1] = MLA_LDK(t5); G.rr[1] = MLA_LDR(t5); G.rv[0] = MLA_LDV(2); G.rv[1] = MLA_LDV(3); }
    mla_qk(L, qf, negm, CA, r, hi);
    mla_qk(L + MLA_KB, qf, negm, CB, r, hi);
    { mla_mask(0, qw0, qi, hi, CA); const float mx = mla_rowmax(CA) + MLA_HEAD; S.m = mx;
#pragma unroll
      for (int kb = 0; kb < 2; ++kb)
#pragma unroll
          for (int reg = 0; reg < 16; ++reg) { CA[kb][reg] = fexp2(CA[kb][reg] - mx); CB[kb][reg] -= mx; }
#pragma unroll
      for (int reg = 0; reg < 16; ++reg) negm[reg] = -mx;
      asm volatile("" : "+v"(negm));
      asm volatile("s_nop 1" : "+v"(CA[0]), "+v"(CA[1]));
      mla_pack(CA, pfO); S.l = mla_rowsum(pfO); }
    MLA_BAR();
#define MLA_DSTEP(t_, TP_) do { const int t__ = (t_); const int tk0 = t__ + 4 < NT ? t__ + 4 : NT - 1, tk1 = t__ + 5 < NT ? t__ + 5 : NT - 1, tv0 = t__ + 2 < NT ? t__ + 2 : NT - 1, tv1 = t__ + 3 < NT ? t__ + 3 : NT - 1; \
        mla_step<true, true, true, true, true, false, TP_>(t__ - 1, qw0, qi, lk0, lv0, qf, negm, o, S, CA, CB, pfO, pfE, vpre, G, lkw, lkr, lvw, \
            bK + (size_t)tk0 * (64 * 1024 * 2), bK + (size_t)tk1 * (64 * 1024 * 2), bR + (size_t)tk0 * (64 * 32 * 2), bR + (size_t)tk1 * (64 * 32 * 2), bV + (size_t)tv0 * (64 * 1024 * 2), bV + (size_t)tv1 * (64 * 1024 * 2), voK, voR, hi); \
        mla_step<true, true, true, false, false, true, TP_ + 1>(t__, qw0, qi, lk0, lv0, qf, negm, o, S, CB, CA, pfE, pfO, vpre, G, lkw, lkr, lvw, bK, bK, bR, bR, bV, bV, 0u, 0u, hi); \
        MLA_BAR(); } while (0)
    MLA_DSTEP(2, 2);
#pragma unroll 1
    for (int t = 4; t < NT; t += 4) { MLA_DSTEP(t, 0); MLA_DSTEP(t + 2, 2); }
    mla_step<false, true, true, false, true, false, 0>(NT - 1, qw0, qi, lk0, lv0, qf, negm, o, S, CA, CB, pfO, pfE, vpre, G, lkw, lkr, lvw, bK, bK, bR, bR, bV, bV, 0u, 0u, hi);
    mla_step<false, true, false, false, false, true, 1>(NT, qw0, qi, lk0, lv0, qf, negm, o, S, CB, CA, pfE, pfO, vpre, G, lkw, lkr, lvw, bK, bK, bR, bR, bV, bV, 0u, 0u, hi);
#undef MLA_DSTEP
#undef MLA_LDK
#undef MLA_LDV
#undef MLA_LDR
#undef MLA_BAR
    float l = S.l; l += __shfl_xor(l, 32); const float inv = frcp(l);
#pragma unroll
    for (int dvb = 0; dvb < 2; ++dvb)
#pragma unroll
        for (int g = 0; g < 4; ++g) { const int v = 32 * dvb + 8 * g + 4 * hi; u32x2 w; w.x = cvt_pk_bf16(o[dvb][4 * g] * inv, o[dvb][4 * g + 1] * inv); w.y = cvt_pk_bf16(o[dvb][4 * g + 2] * inv, o[dvb][4 * g + 3] * inv);
            *(u32x2*)(MIX + (rowb + qi) * 1024 + h * 64 + v) = w; }
    __syncthreads();
}

constexpr int SW_STR = 144, SW_WAVE_BYTES = 2 * 32 * SW_STR;
constexpr int SWA_ROWS = 384, SWA_VOFF = SWA_ROWS * SW_STR, SWA_UNITS = 8 * 3 * 64;
__device__ __forceinline__ void swa_unit_decode(int u, int& b, int& head, int& br, int& dsh, int& rho, int& ib) {
    const int bh = u / 192, rem = u - bh * 192; b = bh >> 2; head = bh & 3; br = rem >> 6; const int j64 = rem & 63;
    dsh = 2 * br; rho = j64 >> (6 - dsh); ib = 256 * (j64 & ((64 >> dsh) - 1));
}
__device__ __forceinline__ void swa_phase(const Frame& F) {
    int tid_ = F.tid; asm volatile("" : "+v"(tid_));
    unsigned char* ws = F.ws; const int tid = tid_, lane = tid & 63, wid = F.wave;
    const bf16_t* PROJ = (const bf16_t*)(ws + WS_PROJ); bf16_t* SWO = (bf16_t*)(ws + WS_SWO); float* SWL = (float*)(ws + WS_SWL);
    const int r = lane & 31, hi = lane >> 5, blk = (lane >> 4) & 1, q = (lane & 15) >> 2, pp = lane & 3;
    LAS unsigned char* Lk = F.lds; LAS unsigned char* Lv = F.lds + SWA_VOFF;
    const int srow = tid >> 3, sch = tid & 7;
    const int vcu = (F.G % 8 == 0) ? (F.bx % 8) * (F.G / 8) + F.bx / 8 : F.bx;
    u32x4 rk[6], rv[6];
#define SWA_ISSUE(u_) do { int b_, head_, br_, dsh_, rho_, ib_; swa_unit_decode((u_), b_, head_, br_, dsh_, rho_, ib_); \
        _Pragma("unroll") for (int i = 0; i < 6; ++i) { int ik = ib_ - 128 + srow + 64 * i; ik = ik < 0 ? 0 : ik; \
            const bf16_t* src = PROJ + ((size_t)b_ * SEQ + rho_ + ((size_t)ik << dsh_)) * D_INP + head_ * 64 + sch * 8; rk[i] = *(const u32x4*)(src + C_SWK); rv[i] = *(const u32x4*)(src + C_SWV); } } while (0)
    f32x16 biasLo, biasHi;
    { const int d = r - 4 * hi;
#pragma unroll
      for (int reg = 0; reg < 16; ++reg) { const int c = (reg & 3) + 8 * (reg >> 2); biasLo[reg] = c < d ? -1e30f : 0.f; biasHi[reg] = c > d ? -1e30f : 0.f; } }
    const bool xl = F.G == 256; const int ustep = xl ? 32 : F.G, uend = xl ? (F.bx % 8) * 192 + 192 : SWA_UNITS;
    int u = xl ? (F.bx % 8) * 192 + F.bx / 8 : vcu;
    if (u < uend) SWA_ISSUE(u);
#pragma unroll 1
    for (; u < uend; u += ustep) {
        int b, head, br, dsh, rho, ib; swa_unit_decode(u, b, head, br, dsh, rho, ib);
        const size_t rowb = (size_t)b * SEQ;
        const int iq = ib + 32 * wid + r; const size_t tokq = rowb + rho + ((size_t)iq << dsh);
        bf16x8 qf[4];
#pragma unroll
        for (int s4 = 0; s4 < 4; ++s4) qf[s4] = *(const bf16x8*)(PROJ + tokq * D_INP + C_SWQ + head * 64 + 16 * s4 + 8 * hi);
#pragma unroll
        for (int i = 0; i < 6; ++i) { *(LAS u32x4*)(Lk + (srow + 64 * i) * SW_STR + sch * 16) = rk[i]; *(LAS u32x4*)(Lv + (srow + 64 * i) * SW_STR + sch * 16) = rv[i]; }
        __syncthreads();
        if (u + ustep < uend) SWA_ISSUE(u + ustep);
        f32x16 st[5];
#pragma unroll
        for (int tau = 0; tau < 5; ++tau) {
            const int lrow = 32 * wid + 32 * tau;
            f32x16 acc = tau == 0 ? biasLo : (tau == 4 ? biasHi : f32x16{});
#pragma unroll
            for (int s4 = 0; s4 < 4; ++s4) { const bf16x8 A = *(const LAS bf16x8*)(Lk + (lrow + r) * SW_STR + (16 * s4 + 8 * hi) * 2); acc = __builtin_amdgcn_mfma_f32_32x32x16_bf16(A, qf[s4], acc, 0, 0, 0); }
            st[tau] = acc;
        }
        if (ib < 128) {
#pragma unroll
            for (int tau = 0; tau < 5; ++tau) { const int e = ib - 128 + 32 * wid + 32 * tau + 4 * hi;
#pragma unroll
                for (int reg = 0; reg < 16; ++reg) { const int c = (reg & 3) + 8 * (reg >> 2); st[tau][reg] = (c + e < 0) ? -1e30f : st[tau][reg]; } }
        }
        float mxa = max3f(st[0][0], st[0][1], st[0][2]), mxb = max3f(st[0][3], st[0][4], st[0][5]);
#pragma unroll
        for (int i = 6; i < 80; i += 4) { mxa = max3f(mxa, st[i >> 4][i & 15], st[(i + 1) >> 4][(i + 1) & 15]); if (i + 2 < 80) mxb = max3f(mxb, st[(i + 2) >> 4][(i + 2) & 15], st[(i + 3) >> 4][(i + 3) & 15]); }
        const float m = swapmax32(fmaxf(mxa, mxb));
        float s0 = 0.f, s1 = 0.f; f32x16 o[2] = {{}, {}};
#pragma unroll
        for (int tau = 0; tau < 5; ++tau) {
            const LAS unsigned char* vt = Lv + (32 * wid + 32 * tau) * SW_STR;
#pragma unroll
            for (int sp = 0; sp < 2; ++sp) {
                u32x4 pw;
#pragma unroll
                for (int j = 0; j < 8; ++j) st[tau][8 * sp + j] = fexp2(st[tau][8 * sp + j] - m);
                asm volatile("s_nop 0" : "+v"(st[tau]));
                pw.x = cvt_pk_bf16(st[tau][8 * sp + 0], st[tau][8 * sp + 1]); pw.y = cvt_pk_bf16(st[tau][8 * sp + 2], st[tau][8 * sp + 3]);
                pw.z = cvt_pk_bf16(st[tau][8 * sp + 4], st[tau][8 * sp + 5]); pw.w = cvt_pk_bf16(st[tau][8 * sp + 6], st[tau][8 * sp + 7]);
                s0 = dot2ones(pw.x, s0); s1 = dot2ones(pw.y, s1); s0 = dot2ones(pw.z, s0); s1 = dot2ones(pw.w, s1);
                const bf16x8 P = __builtin_bit_cast(bf16x8, pw);
#pragma unroll
                for (int dvb = 0; dvb < 2; ++dvb) { const LAS unsigned char* pa = vt + (16 * sp + 4 * hi + q) * SW_STR + (32 * dvb + 16 * blk + 4 * pp) * 2;
                    const bf16x8 A = cat4(tr_read(pa), tr_read(pa + 8 * SW_STR));
                    o[dvb] = __builtin_amdgcn_mfma_f32_32x32x16_bf16(A, P, o[dvb], 0, 0, 0); }
            }
        }
        const float l = s0 + s1;
        const float lt = l + __shfl_xor(l, 32); const float inv = frcp(lt);
#pragma unroll
        for (int dvb = 0; dvb < 2; ++dvb)
#pragma unroll
            for (int g = 0; g < 4; ++g) { const int v = 32 * dvb + 8 * g + 4 * hi; u32x2 w; w.x = cvt_pk_bf16(o[dvb][4 * g] * inv, o[dvb][4 * g + 1] * inv); w.y = cvt_pk_bf16(o[dvb][4 * g + 2] * inv, o[dvb][4 * g + 3] * inv);
                *(u32x2*)(SWO + ((size_t)br * T + tokq) * 256 + head * 64 + v) = w; }
        if (hi == 0) SWL[((size_t)br * T + tokq) * 4 + head] = m + flog2(lt);
        __syncthreads();
    }
#undef SWA_ISSUE
}
__device__ __forceinline__ void swa_merge_phase(const Frame& F, int skip) {
    unsigned char* ws = F.ws; const bf16_t* SWO = (const bf16_t*)(ws + WS_SWO); const float* SWL = (const float*)(ws + WS_SWL); bf16_t* MIX = (bf16_t*)*(float* const CAS*)(F.kp + 192);
    if (F.bx < skip) return;
    for (int it = (F.bx - skip) * 512 + F.tid; it < T * 32; it += (F.G - skip) * 512) {
        const int row = it >> 3, c8 = it & 7; const size_t tok = (size_t)(row >> 2); const int head = row & 3;
        const u32x4 a0 = *(const u32x4*)(SWO + ((size_t)0 * T + tok) * 256 + head * 64 + c8 * 8), a1 = *(const u32x4*)(SWO + ((size_t)1 * T + tok) * 256 + head * 64 + c8 * 8), a2 = *(const u32x4*)(SWO + ((size_t)2 * T + tok) * 256 + head * 64 + c8 * 8);
        const float l0 = SWL[((size_t)0 * T + tok) * 4 + head], l1 = SWL[((size_t)1 * T + tok) * 4 + head], l2 = SWL[((size_t)2 * T + tok) * 4 + head];
        const float M = fmaxf(l0, fmaxf(l1, l2)); float w0 = fexp2(l0 - M), w1 = fexp2(l1 - M), w2 = fexp2(l2 - M); const float iw = 1.0f / (w0 + w1 + w2); w0 *= iw; w1 *= iw; w2 *= iw;
        u32x4 ow;
        ow.x = cvt_pk_bf16(w0 * bflo(a0.x) + w1 * bflo(a1.x) + w2 * bflo(a2.x), w0 * bfhi(a0.x) + w1 * bfhi(a1.x) + w2 * bfhi(a2.x));
        ow.y = cvt_pk_bf16(w0 * bflo(a0.y) + w1 * bflo(a1.y) + w2 * bflo(a2.y), w0 * bfhi(a0.y) + w1 * bfhi(a1.y) + w2 * bfhi(a2.y));
        ow.z = cvt_pk_bf16(w0 * bflo(a0.z) + w1 * bflo(a1.z) + w2 * bflo(a2.z), w0 * bfhi(a0.z) + w1 * bfhi(a1.z) + w2 * bfhi(a2.z));
        ow.w = cvt_pk_bf16(w0 * bflo(a0.w) + w1 * bflo(a1.w) + w2 * bflo(a2.w), w0 * bfhi(a0.w) + w1 * bfhi(a1.w) + w2 * bfhi(a2.w));
        *(u32x4*)(MIX + tok * 1024 + 768 + head * 64 + c8 * 8) = ow;
    }
}

#ifndef SITE_MASK
#define SITE_MASK 0xffffffffu
#endif
#ifndef REP_MASK
#define REP_MASK 0u
#endif
#ifndef REP_SWA
#define REP_SWA 1
#endif
#ifndef REP_ML1
#define REP_ML1 1
#endif
#ifndef REP_G2
#define REP_G2 1
#endif
#ifndef REP_ML3
#define REP_ML3 1
#endif
#ifndef REP_MLA
#define REP_MLA 1
#endif
#ifndef MLA_VAR
#define MLA_VAR 0
#endif
#define PHASE_BEGIN(site) if (((SITE_MASK >> (site)) & 1u) && ph >= lo && ph < hi) { Frame F = make_frame(ldsb, wave0); unsigned char* ws = F.ws; LAS unsigned char* xch = F.lds + XCH_OFF; \
        float* OUT = *(float* const CAS*)(F.kp + 192); bf16_t* XB = (bf16_t*)(ws + WS_H); bf16_t* MIX = (bf16_t*)OUT; float* XS = (float*)(ws + WS_XS); bf16_t* PROJ = (bf16_t*)(ws + WS_PROJ); bf16_t* Yb = (bf16_t*)(ws + WS_Y); (void)OUT; (void)XB; (void)MIX; (void)XS; (void)PROJ; (void)Yb; (void)xch; \
        _Pragma("unroll 1") for (int rep_ = 0; rep_ < (((REP_MASK >> (site)) & 1u) ? 2 : 1); ++rep_) {
#define PHASE_END   } if (ph + 1 < hi) { XcdBarrier bar; bar.bar = (unsigned*)(F.ws + WS_CTL) + 1024; bar.x = xb_xcc_id(); bar.st = (volatile LAS unsigned*)(ldsb + MISC_OFF) + 8; bar.wave0 = wave0; xcd_barrier(bar); } } ++ph;

#define BUILD_XATTN_WEIGHTS(l_) do { unsigned char* wb_ = ws + (((l_) & 1) ? WDELTA : 0); \
        { pg8::Gemm g{(const bf16_t*)(ws + WS_MEMK) + (size_t)(l_) * 512 * 1024, (const bf16_t*)(ws + WS_WXQR), 1024, 1024, 256}; pg8::Order<6> S; S.init(8, 4, F.G, F.bx, 1024, 1024); \
          pg8::EpiStore E{(bf16_t*)(wb_ + WS_WQK), 1024, nullptr}; pg8::gemm_phase(F.lds, xch, g, S, E, F.wave); } \
        { pg8::Gemm g{(const bf16_t*)(ws + WS_WXOT), (const bf16_t*)(ws + WS_MEMV) + (size_t)(l_) * 512 * 1024, 1024, 1024, 256}; pg8::Order<7> S; S.init(8, 4, F.G, F.G >= 64 ? (F.bx + F.G - 32) % F.G : F.bx, 1024, 1024); \
          pg8::EpiStore E{(bf16_t*)(wb_ + WS_WVO), 1024, nullptr}; pg8::gemm_phase(F.lds, xch, g, S, E, F.wave); } } while (0)
template <int l> __device__ __forceinline__ void run_layer(LAS unsigned char* const ldsb, const int wave0, int& ph, const int lo, const int hi) {
        PHASE_BEGIN(2)
            pg8::Gemm g{XB, (const bf16_t*)(ws + WS_WIN + ((l & 1) ? WDELTA : 0)), 1024, 1024, 1024}; pg8::Order<0> S; S.init(T / 256, D_INP / 256, F.G, F.bx, 1024, 1024);
            pg8::EpiProj E{PROJ, XS, (bf16_t*)(ws + WS_KPE), (float*)(ws + WS_GATE), (float*)(ws + WS_SSQ), (const float*)(ws + WS_TMC), (const float*)(ws + WS_TMS), (const float*)(ws + WS_TSC), (const float*)(ws + WS_TSS),
                           F.in(9) + l * 4, F.in(10) + l * 4, 0.125f * LOG2E};
            pg8::gemm_phase(F.lds, xch, g, S, E, F.wave);
            if (2 * F.bx >= F.G) {
                Frame Fc = make_frame(ldsb, wave0); Fc.gw = (Fc.bx - Fc.G / 2) * NWAVES + Fc.wave; Fc.NGW = (Fc.G - Fc.G / 2) * NWAVES; convert_ffn_weights(Fc, l); }
        PHASE_END
        PHASE_BEGIN(4)
            _Pragma("unroll 1") for (int rq = 0; rq < REP_G2; ++rq)
            if ((SITE_MASK >> 17) & 1u) { pg8::Gemm g{PROJ + C_CQ, (const bf16_t*)(ws + WS_WUQ + ((l & 1) ? WDELTA : 0)), D_INP, 256, 256}; pg8::Order<0> S; S.init(T / 256, 3, F.G, F.bx, D_INP, 256);
              pg8::EpiQ E{(bf16_t*)(ws + WS_Q), (const float*)(ws + WS_TMC), (const float*)(ws + WS_TMS), 0.10206207261596577f * LOG2E, (const float*)(ws + WS_SSQ)}; pg8::gemm_phase(F.lds, xch, g, S, E, F.wave); }
            _Pragma("unroll 1") for (int rq = 0; rq < REP_G2; ++rq)
            if ((SITE_MASK >> 18) & 1u) { pg8::Gemm g{PROJ + C_CKV, (const bf16_t*)(ws + WS_WUKV + ((l & 1) ? WDELTA : 0)), D_INP, 128, 128}; pg8::Order<0> S; S.init(T / 256, 4, F.G, F.bx, D_INP, 128);
              pg8::EpiStoreKV E{(bf16_t*)(ws + WS_KV), 1024, (const float*)(ws + WS_SSQ)}; pg8::gemm_phase(F.lds, xch, g, S, E, F.wave); }
            if ((SITE_MASK >> 19) & 1u) { _Pragma("unroll 1") for (int rep = 0; rep < REP_ML1; ++rep) ml1_phase(F, F.in(7) + (size_t)l * 4 * 512, F.in(8) + (size_t)l * 512); }
        PHASE_END
        PHASE_BEGIN(5)
            ml2_phase(F);
            if (F.bx >= ML2_WGS) {
            Frame Fc = F; Fc.gw = (F.bx - ML2_WGS) * NWAVES + F.wave; Fc.NGW = (F.G - ML2_WGS) * NWAVES;
            if (l + 1 < DEPTH) convert_attn_weights(Fc, l + 1);
            }
        PHASE_END
        PHASE_BEGIN(6)
            { const int vcu = (F.G % 8 == 0) ? (F.bx % 8) * (F.G / 8) + F.bx / 8 : F.bx;
_Pragma("unroll 1")
              for (int rep = 0; rep < REP_MLA; ++rep)
              for (int p2 = 2 * vcu; p2 < 1024; p2 += ((p2 & 1) ? 2 * F.G - 1 : 1)) { const int p = p2 >> 1, bh = p >> 5, j = p & 31; mla_unit(F, bh >> 3, bh & 7, (p2 & 1) ? 63 - j : j); }
            }
            { const Frame F2 = make_frame(ldsb, wave0);
_Pragma("unroll 1")
              for (int rep = 0; rep < REP_SWA; ++rep) swa_phase(F2); }
            { const Frame F3 = make_frame(ldsb, wave0);
_Pragma("unroll 1")
              for (int rep = 0; rep < REP_ML3; ++rep) ml3_phase(F3); }
        PHASE_END
        PHASE_BEGIN(3)
            swa_merge_phase(F, (l + 1 < DEPTH && F.G >= 128) ? 64 : 0);
            if (l + 1 < DEPTH) BUILD_XATTN_WEIGHTS(l + 1);
        PHASE_END
        PHASE_BEGIN(7)
            pg8::Gemm g{MIX, (const bf16_t*)(ws + WS_WOUT + ((l & 1) ? WDELTA : 0)), 1024, 1024, 1024}; pg8::Order<0> S; S.init(T / 256, 4, F.G, F.bx, 1024, 1024);

#ifdef PROBE_RESID
            { pg8::EpiResidual<false> Ed{(bf16_t*)(ws + 392 * MiB), nullptr, F.in(18) + l * DM, (float*)(ws + 457 * MiB), (float*)(ws + 456 * MiB), (unsigned*)(ws + WS_CTL + WS_CNT + 8192), 4u * (3 * l + 1), XB}; pg8::gemm_phase(F.lds, xch, g, S, Ed, F.wave); }
#endif
            pg8::EpiResidual<false> E{XB, nullptr, F.in(18) + l * DM, (float*)(ws + WS_SL), XS, (unsigned*)(ws + WS_CTL + WS_CNT), 4u * (3 * l + 1)}; pg8::gemm_phase(F.lds, xch, g, S, E, F.wave);
        PHASE_END
        PHASE_BEGIN(9)
            pg8::Gemm g{XB, (const bf16_t*)(ws + WS_WQK + ((l & 1) ? WDELTA : 0)), 1024, 1024, 1024}; pg8::Order<5> S; S.init(T / 256, 4, F.G, F.bx, 1024, 1024);
            pg8::EpiSoftmax E{(bf16_t*)(ws + WS_P), 0.0625f * LOG2E, XS}; pg8::gemm_phase(F.lds, xch, g, S, E, F.wave);
        PHASE_END
        PHASE_BEGIN(12)
            pg8::Gemm g{(const bf16_t*)(ws + WS_P), (const bf16_t*)(ws + WS_WVO + ((l & 1) ? WDELTA : 0)), 1024, 1024, 1024}; pg8::Order<5> S; S.init(T / 256, 4, F.G, F.bx, 1024, 1024);

#ifdef PROBE_RESID
            { pg8::EpiResidual<false> Ed{(bf16_t*)(ws + 392 * MiB), nullptr, F.in(21) + l * DM, (float*)(ws + 457 * MiB), (float*)(ws + 456 * MiB), (unsigned*)(ws + WS_CTL + WS_CNT + 8192), 4u * (3 * l + 2), XB}; pg8::gemm_phase(F.lds, xch, g, S, Ed, F.wave); }
#endif
            pg8::EpiResidual<false> E{XB, nullptr, F.in(21) + l * DM, (float*)(ws + WS_SL), XS, (unsigned*)(ws + WS_CTL + WS_CNT), 4u * (3 * l + 2)}; pg8::gemm_phase(F.lds, xch, g, S, E, F.wave);
        PHASE_END
#ifdef PROBE_G8PHASE
        PHASE_BEGIN(20)
            pg8::Gemm g{XB, (const bf16_t*)(ws + WS_WGU), 1024, 1024, 1024}; pg8::Order<0> S; S.init(T / 256, 22, F.G, F.bx, 1024, 1024);
            pg8::EpiSwiGLU E{(bf16_t*)(ws + 136 * MiB), XS}; pg8::gemm_phase(F.lds, xch, g, S, E, F.wave);
        PHASE_END
#endif
        PHASE_BEGIN(14)
            pg8::Gemm g{XB, (const bf16_t*)(ws + WS_WGU), 1024, 1024, 1024}; pg8::Order<0> S; S.init(T / 256, 22, F.G, F.bx, 1024, 1024);
            pg8::EpiSwiGLU E{(bf16_t*)(ws + WS_ACT), XS}; pg8::gemm_phase(F.lds, xch, g, S, E, F.wave);
        PHASE_END
        PHASE_BEGIN(15)
            pg8::Gemm g{(const bf16_t*)(ws + WS_ACT), (const bf16_t*)(ws + WS_WDN), D_FF, D_FF, D_FF}; pg8::Order<0> S; S.init(T / 256, 4, F.G, F.bx, D_FF, D_FF);
            if (l + 1 < DEPTH) {
#ifdef PROBE_RESID
            { pg8::EpiResidual<false> Ed{(bf16_t*)(ws + 392 * MiB), nullptr, F.in(23) + l * DM, (float*)(ws + 457 * MiB), (float*)(ws + 456 * MiB), (unsigned*)(ws + WS_CTL + WS_CNT + 8192), 4u * (3 * l + 3), XB}; pg8::gemm_phase(F.lds, xch, g, S, Ed, F.wave); }
#endif
            pg8::EpiResidual<false> E{XB, nullptr, F.in(23) + l * DM, (float*)(ws + WS_SL), XS, (unsigned*)(ws + WS_CTL + WS_CNT), 4u * (3 * l + 3)}; pg8::gemm_phase(F.lds, xch, g, S, E, F.wave); }
            else {
#ifdef PROBE_RESID
            { pg8::EpiResidual<false> Ed{(bf16_t*)(ws + 392 * MiB), nullptr, F.in(23) + l * DM, (float*)(ws + 457 * MiB), (float*)(ws + 456 * MiB), (unsigned*)(ws + WS_CTL + WS_CNT + 8192), 4u * (3 * l + 3), XB}; pg8::gemm_phase(F.lds, xch, g, S, Ed, F.wave); }
#endif
            pg8::EpiResidual<true> E{XB, OUT, F.in(23) + l * DM, (float*)(ws + WS_SL), XS, (unsigned*)(ws + WS_CTL + WS_CNT), 4u * (3 * l + 3)}; pg8::gemm_phase(F.lds, xch, g, S, E, F.wave); }
        PHASE_END
}

__global__ void __launch_bounds__(NWAVES * 64, 2) trunk_fwd(Args args) {
    extern __shared__ __attribute__((aligned(16))) unsigned char lds_raw[];
    LAS unsigned char* const ldsb = (LAS unsigned char*)lds_raw;
    { volatile LAS unsigned* MISC = (volatile LAS unsigned*)(ldsb + MISC_OFF);
      if (threadIdx.x < 32) MISC[threadIdx.x] = 0u;
      __syncthreads();
      (void)xcd_barrier_post((unsigned*)(args.ws + WS_CTL) + 1024, MISC + 8); }
    const int wave0 = __builtin_amdgcn_readfirstlane(threadIdx.x >> 6);
    const int lo = args.ph_lo, hi = args.ph_hi;
    int ph = 0;
    PHASE_BEGIN(0)
        prologue_prereq(F);
    PHASE_END
    PHASE_BEGIN(1)
        { const int NG = F.G >= 128 ? 64 : 0;
          if (F.bx >= NG) { Frame Fe = F; Fe.bx = F.bx - NG; Fe.G = F.G - NG; Fe.gw = Fe.bx * NWAVES + F.wave; Fe.NGW = Fe.G * NWAVES;
              convert_attn_weights(Fe, 0); prologue_rope(Fe); resid_init_phase(Fe, F.in(0), XB, XS); }
          __syncthreads(); }
        { pg8::Gemm g{(const bf16_t*)(ws + WS_MEMN), (const bf16_t*)(ws + WS_WXKVT), 1024, 1024, 1024}; pg8::Order<3> S; S.init(8, 4, F.G, F.bx, 1024, 1024);
          pg8::EpiStore E{(bf16_t*)(ws + WS_MEMK), 1024, nullptr}; pg8::gemm_phase(F.lds, xch, g, S, E, F.wave); }
        { pg8::Gemm g{(const bf16_t*)(ws + WS_MEMN), (const bf16_t*)(ws + WS_WXKVT), 1024, 1024, 1024}; pg8::Order<4> S; S.init(8, 4, F.G, F.G >= 64 ? (F.bx + F.G - 32) % F.G : F.bx, 1024, 1024);
          pg8::EpiStore E{(bf16_t*)(ws + WS_MEMV), 1024, nullptr}; pg8::gemm_phase(F.lds, xch, g, S, E, F.wave); }
    PHASE_END
    PHASE_BEGIN(17)
        BUILD_XATTN_WEIGHTS(0);
    PHASE_END

    run_layer<0>(ldsb, wave0, ph, lo, hi); run_layer<1>(ldsb, wave0, ph, lo, hi); run_layer<2>(ldsb, wave0, ph, lo, hi); run_layer<3>(ldsb, wave0, ph, lo, hi);
}
#undef PHASE_BEGIN
#undef PHASE_END

#ifndef PH_STOP
#define PH_STOP 1000
#endif
extern "C" void kernel_launch(void* const* d_in, const int* in_sizes, int n_in, void* d_out, int out_size, void* d_ws, size_t ws_size, hipStream_t stream) {
    static int grid = 0;
    if (grid == 0) {
        if (n_in != 24 || out_size != T * DM || ws_size < WS_END) { fprintf(stderr, "kernel_launch: unexpected sizes n_in %d out %d ws %zu\n", n_in, out_size, ws_size); grid = -1; return; }
        int dev = 0, cus = 0, per_cu = 0;
        if (hipGetDevice(&dev) != hipSuccess || hipDeviceGetAttribute(&cus, hipDeviceAttributeMultiprocessorCount, dev) != hipSuccess) { grid = -1; return; }
        if (hipFuncSetAttribute((const void*)trunk_fwd, hipFuncAttributeMaxDynamicSharedMemorySize, LDS_BYTES) != hipSuccess) { fprintf(stderr, "kernel_launch: hipFuncSetAttribute failed\n"); grid = -1; return; }
        if (hipOccupancyMaxActiveBlocksPerMultiprocessor(&per_cu, (const void*)trunk_fwd, NWAVES * 64, LDS_BYTES) != hipSuccess || per_cu < 1) { fprintf(stderr, "kernel_launch: occupancy query says %d\n", per_cu); }
        (void)hipGetLastError();
        grid = cus;
    }
    if (grid < 0) return;
    hipMemsetAsync((char*)d_ws + WS_CTL, 0, CTL_ZERO_BYTES, stream);
    Args a{};
    for (int i = 0; i < 24; ++i) a.in[i] = (const float*)d_in[i];
    a.out = (float*)d_out; a.ws = (unsigned char*)d_ws; a.ph_lo = 0; a.ph_hi = PH_STOP;
    hipLaunchKernelGGL(trunk_fwd, dim3(grid), dim3(NWAVES * 64), LDS_BYTES, stream, a);
}
```
